# Optimizing an MI355X kernel written in HIP

```python
import jax, jax.numpy as jnp
from jax import lax
import numpy as np

D_MODEL = 2048
BATCH = 4
SEQ = 2048
DEPTH = 4
DEC_BATCH = 128
DEC_SEQ = 8
PAST_LEN = 16384
PAGE_SIZE = 128

N_MIXERS = 3
N_LAYERS_A = (DEPTH + 2) // 3
N_LAYERS_B = (DEPTH + 1) // 3
N_LAYERS_C = DEPTH // 3
D_FF = ((8 * D_MODEL // 3 + 127) // 128) * 128
CHUNK = 128
D_A = D_MODEL
N_GROUPS_A = D_A // 128
HEAD_A = D_A // N_GROUPS_A
POOL_WINDOWS = (2, 4, 8, 16)
N_POOL_GROUPS = 4
POOL_GROUP = D_MODEL // N_POOL_GROUPS
POOL_HIST = 15
D_C = D_MODEL
CONV_W = 3
ALPHA = (2 * DEPTH) ** 0.25
BETA = (8 * DEPTH) ** -0.25
LN_EPS = 1e-5

kernel_name = 'hybrid_chunkmlp_pool_conv_decoder'


def layer_norm(x, g, b):
    xf = x.astype(jnp.float32)
    mu = xf.mean(-1, keepdims=True)
    var = jnp.square(xf - mu).mean(-1, keepdims=True)
    return ((xf - mu) * lax.rsqrt(var + LN_EPS) * g.astype(jnp.float32) + b.astype(jnp.float32)).astype(x.dtype)


def post_norm(x, delta, g, b):
    return layer_norm(ALPHA * x + delta, g, b)


def swiglu(x, w_gu, w_down):
    gate, up = jnp.split(x @ w_gu, 2, axis=-1)
    return (jax.nn.silu(gate) * up) @ w_down


def chunk_mlp_mixer(x, w_in, ln_g, ln_b, w_s, b_s, w_out):
    bsz, t, _ = x.shape
    u, v = jnp.split(jax.nn.gelu(x @ w_in, approximate=False), 2, axis=-1)
    v = layer_norm(v, ln_g, ln_b)
    pad = (-t) % CHUNK
    n = (t + pad) // CHUNK
    vp = jnp.pad(v, ((0, 0), (0, pad), (0, 0))).reshape(bsz, n, CHUNK, N_GROUPS_A, HEAD_A)
    causal = jnp.tril(jnp.ones((CHUNK, CHUNK), dtype=bool))
    wm = jnp.where(causal[None], w_s, 0)
    mixed = jnp.einsum('hts,bnshd->bnthd', wm, vp) + b_s.T[:, :, None]
    mixed = mixed.reshape(bsz, n * CHUNK, D_A)[:, :t]
    return (u * mixed) @ w_out, v


def pool_mixer(x, hist, start_pos, w_grp, scale):
    bsz, t, d = x.shape
    xe = jnp.concatenate([hist.astype(x.dtype), x], axis=1).astype(jnp.float32)
    cs = jnp.pad(jnp.cumsum(xe, axis=1), ((0, 0), (1, 0), (0, 0)))
    pos = start_pos + jnp.arange(t)
    end = cs[:, POOL_HIST + 1:POOL_HIST + 1 + t]
    means = []
    for g, w in enumerate(POOL_WINDOWS):
        sl = slice(g * POOL_GROUP, (g + 1) * POOL_GROUP)
        begin = cs[:, POOL_HIST + 1 - w:POOL_HIST + 1 - w + t, sl]
        cnt = jnp.minimum(pos + 1, w).astype(jnp.float32)
        means.append((end[..., sl] - begin) / cnt[None, :, None])
    pooled = (jnp.concatenate(means, axis=-1) - xe[:, POOL_HIST:]).astype(x.dtype)
    pooled = pooled.reshape(bsz, t, N_POOL_GROUPS, POOL_GROUP)
    y = jnp.einsum('btgc,gcd->btgd', pooled, w_grp).reshape(bsz, t, d)
    return y * scale, xe[:, -POOL_HIST:].astype(x.dtype)


def conv_mixer(x, hist, w_in, w_conv, w_out):
    t = x.shape[1]
    b_gate, c_gate, h = jnp.split(x @ w_in, 3, axis=-1)
    z = c_gate * h
    ze = jnp.concatenate([hist.astype(z.dtype), z], axis=1)
    conv = w_conv[CONV_W - 1] * ze[:, CONV_W - 1:CONV_W - 1 + t]
    for k in range(CONV_W - 1):
        conv = conv + w_conv[k] * ze[:, k:k + t]
    return (b_gate * conv) @ w_out, ze[:, -(CONV_W - 1):]


def setup_inputs(seed: int = 0) -> dict:
    key = jax.random.key(seed)
    ks = jax.random.split(key, 32)

    def nrm(k, shape, scale):
        return jax.random.normal(k, shape, jnp.float32) * scale

    return {
        'x_prompt': nrm(ks[0], (BATCH, SEQ, D_MODEL), 1.0),
        'x_sample': nrm(ks[1], (DEC_BATCH, DEC_SEQ, D_MODEL), 1.0),
        'state_pool': nrm(ks[2], (N_LAYERS_B, DEC_BATCH, POOL_HIST, D_MODEL), 1.0),
        'state_conv': nrm(ks[3], (N_LAYERS_C, DEC_BATCH, CONV_W - 1, D_C), 1.0),
        'ffn1_w_gu': nrm(ks[4], (DEPTH, D_MODEL, 2 * D_FF), D_MODEL ** -0.5),
        'ffn1_w_down': nrm(ks[5], (DEPTH, D_FF, D_MODEL), BETA * D_FF ** -0.5),
        'ffn2_w_gu': nrm(ks[6], (DEPTH, D_MODEL, 2 * D_FF), D_MODEL ** -0.5),
        'ffn2_w_down': nrm(ks[7], (DEPTH, D_FF, D_MODEL), BETA * D_FF ** -0.5),
        'ln1_g': 1.0 + nrm(ks[8], (DEPTH, D_MODEL), 0.05),
        'ln1_b': nrm(ks[9], (DEPTH, D_MODEL), 0.02),
        'ln2_g': 1.0 + nrm(ks[10], (DEPTH, D_MODEL), 0.05),
        'ln2_b': nrm(ks[11], (DEPTH, D_MODEL), 0.02),
        'ln3_g': 1.0 + nrm(ks[12], (DEPTH, D_MODEL), 0.05),
        'ln3_b': nrm(ks[13], (DEPTH, D_MODEL), 0.02),
        'a_w_in': nrm(ks[14], (N_LAYERS_A, D_MODEL, 2 * D_A), D_MODEL ** -0.5),
        'a_ln_g': 1.0 + nrm(ks[15], (N_LAYERS_A, D_A), 0.05),
        'a_ln_b': nrm(ks[16], (N_LAYERS_A, D_A), 0.02),
        'a_w_s': nrm(ks[17], (N_LAYERS_A, N_GROUPS_A, CHUNK, CHUNK), CHUNK ** -0.5),
        'a_b_s': 1.0 + nrm(ks[18], (N_LAYERS_A, N_GROUPS_A, CHUNK), 0.05),
        'a_w_out': nrm(ks[19], (N_LAYERS_A, D_A, D_MODEL), BETA * D_A ** -0.5),
        'b_w_grp': nrm(ks[20], (N_LAYERS_B, N_POOL_GROUPS, POOL_GROUP, POOL_GROUP), BETA * POOL_GROUP ** -0.5),
        'b_scale': 1.0 + nrm(ks[21], (N_LAYERS_B, D_MODEL), 0.1),
        'c_w_in': nrm(ks[22], (N_LAYERS_C, D_MODEL, 3 * D_C), D_MODEL ** -0.5),
        'c_w_conv': nrm(ks[23], (N_LAYERS_C, CONV_W, D_C), CONV_W ** -0.5),
        'c_w_out': nrm(ks[24], (N_LAYERS_C, D_C, D_MODEL), BETA * D_C ** -0.5),
    }


def reference(x_prompt, x_sample, state_pool, state_conv,
              ffn1_w_gu, ffn1_w_down, ffn2_w_gu, ffn2_w_down,
              ln1_g, ln1_b, ln2_g, ln2_b, ln3_g, ln3_b,
              a_w_in, a_ln_g, a_ln_b, a_w_s, a_b_s, a_w_out,
              b_w_grp, b_scale,
              c_w_in, c_w_conv, c_w_out):
    xp, xs = x_prompt, x_sample
    pool_p, pool_s, conv_p, conv_s, chunk_v_s = [], [], [], [], []
    for i in range(DEPTH):
        kind, j = i % N_MIXERS, i // N_MIXERS
        xp = post_norm(xp, 0.5 * swiglu(xp, ffn1_w_gu[i], ffn1_w_down[i]), ln1_g[i], ln1_b[i])
        xs = post_norm(xs, 0.5 * swiglu(xs, ffn1_w_gu[i], ffn1_w_down[i]), ln1_g[i], ln1_b[i])
        if kind == 0:
            mp, _ = chunk_mlp_mixer(xp, a_w_in[j], a_ln_g[j], a_ln_b[j], a_w_s[j], a_b_s[j], a_w_out[j])
            ms, vs = chunk_mlp_mixer(xs, a_w_in[j], a_ln_g[j], a_ln_b[j], a_w_s[j], a_b_s[j], a_w_out[j])
            chunk_v_s.append(vs)
        elif kind == 1:
            zero_hist = jnp.zeros((xp.shape[0], POOL_HIST, D_MODEL), xp.dtype)
            mp, hp = pool_mixer(xp, zero_hist, 0, b_w_grp[j], b_scale[j])
            ms, hs = pool_mixer(xs, state_pool[j], PAST_LEN, b_w_grp[j], b_scale[j])
            pool_p.append(hp)
            pool_s.append(hs)
        else:
            zero_hist = jnp.zeros((xp.shape[0], CONV_W - 1, D_C), xp.dtype)
            mp, hp = conv_mixer(xp, zero_hist, c_w_in[j], c_w_conv[j], c_w_out[j])
            ms, hs = conv_mixer(xs, state_conv[j], c_w_in[j], c_w_conv[j], c_w_out[j])
            conv_p.append(hp)
            conv_s.append(hs)
        xp = post_norm(xp, mp, ln2_g[i], ln2_b[i])
        xs = post_norm(xs, ms, ln2_g[i], ln2_b[i])
        xp = post_norm(xp, 0.5 * swiglu(xp, ffn2_w_gu[i], ffn2_w_down[i]), ln3_g[i], ln3_b[i])
        xs = post_norm(xs, 0.5 * swiglu(xs, ffn2_w_gu[i], ffn2_w_down[i]), ln3_g[i], ln3_b[i])
    return (xp, xs, jnp.stack(pool_p), jnp.stack(pool_s), jnp.stack(conv_p), jnp.stack(conv_s), jnp.stack(chunk_v_s))
```

```cpp
#include <hip/hip_runtime.h>
#include <cstdio>
#include <cstdint>

#define PG8_BK32 1
#define PG8_ASYM 0
#define FUSE_LN 1
#define SUB_ON 1
#define REP_PRO 1
#define REP_UP 1
#define REP_DOWN0 1
#define REP_LN 1
#define REP_LNV 1
#define REP_BAR 1
#define REP_MG 1
#define REP_MIX 1
#define REP_POOL 1
#define REP_CG 1
#ifndef MK_PER_PHASE
#define MK_PER_PHASE 0
#endif

constexpr int DM = 2048, SEQ = 2048, NBATCH = 4, DECB = 128, DECS = 8, DFF = 5504;
constexpr int MP = NBATCH * SEQ, MS = DECB * DECS, M = MP + MS;
constexpr int LDK = DM + 64;
constexpr float ALPHA = 1.6817928305074290861f;
constexpr float LN_EPS = 1e-5f;
constexpr size_t OFF_Y = 0, OFF_PP = (size_t)M * DM, OFF_PS = OFF_PP + (size_t)NBATCH * 15 * DM, OFF_CP = OFF_PS + (size_t)DECB * 15 * DM,
                 OFF_CS = OFF_CP + (size_t)NBATCH * 2 * DM, OFF_CV = OFF_CS + (size_t)DECB * 2 * DM, OUT_TOTAL = OFF_CV + (size_t)2 * MS * DM;

namespace pg8 {
#define PG8_LAS __attribute__((address_space(3)))
typedef unsigned short bf16_t;
typedef short bf16x8 __attribute__((ext_vector_type(8)));
typedef float f32x4 __attribute__((ext_vector_type(4)));
typedef float f32x2 __attribute__((ext_vector_type(2)));
typedef unsigned u32x4 __attribute__((ext_vector_type(4)));
typedef unsigned u32x2 __attribute__((ext_vector_type(2)));
constexpr int BM = 256, BK = 64, HALF = 128, HTB = HALF * BK * 2  , STAGE_BYTES = 8 * HTB, NXCD = 8, WGM = 4;

__host__ __device__ __forceinline__ int lds_byte(int r, int c) { const int st = (r >> 4) * 2 + (c >> 5), rr = r & 15, cc = c & 31, ob = rr * 64 + cc * 2; return st * 1024 + (ob ^ (((ob >> 9) & 1) << 5)); }
__host__ __device__ __forceinline__ void stage_rc(int b, int& R, int& C) { const int st = b / 1024, sb = b % 1024, swz = sb ^ (((sb >> 9) & 1) << 5); R = (st >> 1) * 16 + swz / 64; C = (st & 1) * 32 + (swz % 64) / 2; }
__host__ __device__ __forceinline__ int perm32(int rho) { const int n = rho >> 4, i = rho & 15; return 8 * (i >> 2) + 4 * n + (i & 3); }

struct Unit { int pm, pn; };
struct Gemm { const bf16_t* A; const bf16_t* Bt; int lda, ldb, K, grp_tiles, grp_koff; long ksa, ksb; };

struct DpOrder {
    int nM, nN, nx, j, base, Tx, Rdp, rem;
    __device__ __forceinline__ void init(int nM_, int nN_, int G, int bx, bool sub) {
        asm volatile("" : "+s"(bx), "+s"(G));
        nM = nM_; nN = nN_; const int nwg = nM * nN, NX = (G % NXCD == 0) ? NXCD : 1; nx = G / NX; const int x = bx % NX; j = bx / NX;
        const int q = nwg / NX, r = nwg % NX; Tx = q + (x < r ? 1 : 0); base = x < r ? x * (q + 1) : r * (q + 1) + (x - r) * q;
        Rdp = Tx / nx; rem = Tx % nx; if (!sub && rem) { ++Rdp; rem = 0; }
        Tx = __builtin_amdgcn_readfirstlane(Tx); base = __builtin_amdgcn_readfirstlane(base); Rdp = __builtin_amdgcn_readfirstlane(Rdp); rem = __builtin_amdgcn_readfirstlane(rem); j = __builtin_amdgcn_readfirstlane(j); nx = __builtin_amdgcn_readfirstlane(nx);
    }
    __device__ __forceinline__ void tile(int wgid, Unit& u) const { const int nig = WGM * nN, gid = wgid / nig, fm = gid * WGM, gsz = (nM - fm) < WGM ? (nM - fm) : WGM;
        u.pm = __builtin_amdgcn_readfirstlane(fm + ((wgid % nig) % gsz)); u.pn = __builtin_amdgcn_readfirstlane((wgid % nig) / gsz); }
    __device__ __forceinline__ bool next(int i, Unit& u) const { if (i >= Rdp || nx * i + j >= Tx) return false; tile(base + nx * i + j, u); return true; }
    __device__ __forceinline__ bool next_sub(int i, Unit& u, int& sub) const { const int su = nx * i + j; if (su >= 8 * rem) return false; tile(base + Rdp * nx + (su >> 3), u); sub = su & 7; return true; }
    __device__ __forceinline__ bool hasx(const Unit&) const { return true; }
    __device__ __forceinline__ void a_ready(const Unit&) const {}
    __device__ __forceinline__ void done(const Unit&) const {}
};

__device__ __forceinline__ unsigned cvt_pk_bf16(float lo, float hi) { unsigned r; asm volatile("v_cvt_pk_bf16_f32 %0, %1, %2" : "=v"(r) : "v"(lo), "v"(hi)); return r; }
__device__ __forceinline__ f32x2 gelu_pk(f32x2 v) {
    const f32x2 av = __builtin_elementwise_abs(v), d = av * 0.2316418882f + 1.0f;
    f32x2 t; t.x = __builtin_amdgcn_rcpf(d.x); t.y = __builtin_amdgcn_rcpf(d.y);
    f32x2 q = t * 0.5307027145f + (-0.7265760135f); q = q * t + 0.7107068705f; q = q * t + (-0.142248368f); q = q * t + 0.127414796f; q = q * t;
    const f32x2 s = (v * v) * (-0.72134752044f);
    f32x2 e; e.x = __builtin_amdgcn_exp2f(s.x); e.y = __builtin_amdgcn_exp2f(s.y);
    const f32x2 m = v * (q * e), r = v - m;
    f32x2 o; o.x = v.x < 0.f ? m.x : r.x; o.y = v.y < 0.f ? m.y : r.y; return o;
}
__device__ __forceinline__ float silu_f(float g) { return g * __builtin_amdgcn_rcpf(1.0f + __builtin_amdgcn_exp2f(g * -1.4426950408889634f)); }
__device__ __forceinline__ u32x4 pack8(const f32x4& a, const f32x4& b) { u32x4 w; w.x = cvt_pk_bf16(a[0], a[1]); w.y = cvt_pk_bf16(a[2], a[3]); w.z = cvt_pk_bf16(b[0], b[1]); w.w = cvt_pk_bf16(b[2], b[3]); return w; }
__device__ __forceinline__ __amdgpu_buffer_rsrc_t wt_rsrc(const void* base) { return __builtin_amdgcn_make_buffer_rsrc((void*)base, 0, 0x7fffffff, 0x00020000); }
#define PG8_EPI_CALL() \
    __device__ __forceinline__ void operator()(const f32x4 (&acc)[2][2][4][2], const Unit& u, int wr, int wc, int fr, int fq) const { \
        _Pragma("unroll") for (int ai = 0; ai < 2; ++ai) _Pragma("unroll") for (int m = 0; m < 4; ++m) \
            grp(acc[ai][0][m][0], acc[ai][0][m][1], acc[ai][1][m][0], acc[ai][1][m][1], u, u.pm * BM + ai * HALF + wr * 64 + m * 16 + fr, wc, fq); }

template <int ACT> struct EpiBf16 {
    static constexpr bool PERM = true, AFTER_DRAIN = false;
    bf16_t* O; int ldc; float* vst;
    __device__ __forceinline__ void grp(f32x4 v00, f32x4 v01, f32x4 v10, f32x4 v11, const Unit& u, int row, int wc, int fq) const {
        bf16_t* rowp = O + (size_t)row * ldc + u.pn * BM + wc * 32 + 8 * fq;
        if (ACT == 1) { f32x2 a = gelu_pk((f32x2){v00[0], v00[1]}), b = gelu_pk((f32x2){v00[2], v00[3]}), c = gelu_pk((f32x2){v01[0], v01[1]}), d = gelu_pk((f32x2){v01[2], v01[3]});
            v00 = (f32x4){a.x, a.y, b.x, b.y}; v01 = (f32x4){c.x, c.y, d.x, d.y};
            a = gelu_pk((f32x2){v10[0], v10[1]}); b = gelu_pk((f32x2){v10[2], v10[3]}); c = gelu_pk((f32x2){v11[0], v11[1]}); d = gelu_pk((f32x2){v11[2], v11[3]});
            v10 = (f32x4){a.x, a.y, b.x, b.y}; v11 = (f32x4){c.x, c.y, d.x, d.y}; }
        *(u32x4*)rowp = pack8(v00, v01); *(u32x4*)(rowp + HALF) = pack8(v10, v11);
        if (vst && u.pn >= 8) { const int lane = (row & 15) + 16 * fq;
            float s1 = ((v00[0] + v00[1]) + (v00[2] + v00[3])) + ((v01[0] + v01[1]) + (v01[2] + v01[3])) + ((v10[0] + v10[1]) + (v10[2] + v10[3])) + ((v11[0] + v11[1]) + (v11[2] + v11[3]));
            float s2 = ((v00[0] * v00[0] + v00[1] * v00[1]) + (v00[2] * v00[2] + v00[3] * v00[3])) + ((v01[0] * v01[0] + v01[1] * v01[1]) + (v01[2] * v01[2] + v01[3] * v01[3]))
                     + ((v10[0] * v10[0] + v10[1] * v10[1]) + (v10[2] * v10[2] + v10[3] * v10[3])) + ((v11[0] * v11[0] + v11[1] * v11[1]) + (v11[2] * v11[2] + v11[3] * v11[3]));
#pragma unroll
            for (int o = 16; o < 64; o <<= 1) { s1 += __builtin_bit_cast(float, __builtin_amdgcn_ds_bpermute((lane ^ o) << 2, __builtin_bit_cast(int, s1))); s2 += __builtin_bit_cast(float, __builtin_amdgcn_ds_bpermute((lane ^ o) << 2, __builtin_bit_cast(int, s2))); }
            if (fq == 0) *(f32x2*)(vst + (((size_t)row * 8 + (u.pn - 8)) * 4 + wc) * 2) = (f32x2){s1, s2}; }
    }
    PG8_EPI_CALL()
};
struct EpiSwiGLU {
    static constexpr bool PERM = true, AFTER_DRAIN = false;
    bf16_t* O; int ldc;
    __device__ __forceinline__ void grp(f32x4 g0, f32x4 g1, f32x4 u0, f32x4 u1, const Unit& u, int row, int wc, int fq) const {
        f32x4 h0, h1;
#pragma unroll
        for (int e = 0; e < 4; ++e) { h0[e] = silu_f(g0[e]) * u0[e]; h1[e] = silu_f(g1[e]) * u1[e]; }
        const int col = u.pn * HALF + wc * 32 + 8 * fq;
        *(u32x4*)(O + ((size_t)(col >> 5) * M + row) * 32 + (col & 31)) = pack8(h0, h1);
    }
    PG8_EPI_CALL()
};
struct EpiConvIn {
    static constexpr bool PERM = true, AFTER_DRAIN = false;
    bf16_t* BZ; float* out_cp; float* out_cs;
    __device__ __forceinline__ void grp(f32x4 v00, f32x4 v01, f32x4 v10, f32x4 v11, const Unit& u, int row, int wc, int fq) const {
        if (u.pn < 8) { bf16_t* rowp = BZ + (size_t)row * 4096 + u.pn * BM + wc * 32 + 8 * fq; *(u32x4*)rowp = pack8(v00, v01); *(u32x4*)(rowp + HALF) = pack8(v10, v11); }
        else { const int col0 = (u.pn - 8) * HALF + wc * 32 + 8 * fq; const f32x4 z0 = v00 * v10, z1 = v01 * v11;
            *(u32x4*)(BZ + (size_t)row * 4096 + 2048 + col0) = pack8(z0, z1);
            if (row < MP) { const int t = row & (SEQ - 1);
                if (t >= SEQ - 2) { float* o = out_cp + ((size_t)(row >> 11) * 2 + (t - (SEQ - 2))) * DM + col0; *(f32x4*)o = z0; *(f32x4*)(o + 4) = z1; } }
            else { const int lr = row - MP, t = lr & 7;
                if (t >= 6) { float* o = out_cs + ((size_t)(lr >> 3) * 2 + (t - 6)) * DM + col0; *(f32x4*)o = z0; *(f32x4*)(o + 4) = z1; } } }
    }
    PG8_EPI_CALL()
};
struct EpiResid {
    static constexpr bool PERM = false, AFTER_DRAIN = false;
    const float* res_p; const float* res_s; float* out; const float* colscale; float s;
    __device__ __forceinline__ void grp(f32x4 v00, f32x4 v01, f32x4 v10, f32x4 v11, const Unit& u, int row, int wc, int fq) const {
        const int col0 = u.pn * BM + wc * 32 + 4 * fq;
        const float* rp = ((row < MP) ? res_p + (size_t)row * DM : res_s + (size_t)(row - MP) * DM) + col0; float* op = out + (size_t)row * DM + col0;
        f32x4 c00 = (f32x4){s, s, s, s}, c01 = c00, c10 = c00, c11 = c00;
        if (colscale) { c00 = *(const f32x4*)(colscale + col0) * s; c01 = *(const f32x4*)(colscale + col0 + 16) * s; c10 = *(const f32x4*)(colscale + col0 + HALF) * s; c11 = *(const f32x4*)(colscale + col0 + HALF + 16) * s; }
        const f32x4 r00 = *(const f32x4*)rp, r01 = *(const f32x4*)(rp + 16), r10 = *(const f32x4*)(rp + HALF), r11 = *(const f32x4*)(rp + HALF + 16);
        *(f32x4*)op = r00 * ALPHA + v00 * c00; *(f32x4*)(op + 16) = r01 * ALPHA + v01 * c01; *(f32x4*)(op + HALF) = r10 * ALPHA + v10 * c10; *(f32x4*)(op + HALF + 16) = r11 * ALPHA + v11 * c11;
    }
    PG8_EPI_CALL()
};

struct UpOrder {
    int bx, part;
    __device__ __forceinline__ void unit(int r, Unit& u) const { const int x = bx & 7, i = 32 * r + (bx >> 3);
        if (i < 172) { u.pm = 4 * x + (i & 3); u.pn = i >> 2; } else { u.pm = 32 + (x >> 1); u.pn = (x & 1) * 20 + (i - 172); } }
    __device__ __forceinline__ bool host() const { return (bx >> 3) < 12; }
    __device__ __forceinline__ bool next(int r, Unit& u) const {
        if (part == 0) { if (r >= 6 || (r == 5 && host())) return false; unit(r, u); return true; }
        if (r > 0 || !host()) return false; unit(5, u); return true; }
    __device__ __forceinline__ bool hasx(const Unit&) const { return true; }
    __device__ __forceinline__ void a_ready(const Unit&) const {}
    __device__ __forceinline__ void done(const Unit&) const {}
};
struct PanelOrder {
    int bx;
    __device__ __forceinline__ bool next(int i, Unit& u) const { if (i) return false; const int x = bx & 7, j = bx >> 3; u.pm = 4 * x + (j >> 3); u.pn = j & 7; return true; }
    __device__ __forceinline__ bool hasx(const Unit&) const { return true; }
    __device__ __forceinline__ void a_ready(const Unit&) const {}
    __device__ __forceinline__ void done(const Unit&) const {}
};
struct EpiResidLN {
    static constexpr bool PERM = true, AFTER_DRAIN = true;
    float* out; const float* colscale; float s;
    const float* lng; const float* lnb; bf16_t* xb; unsigned long long* slots; unsigned* cnt; unsigned* tmo;
    typedef __attribute__((address_space(1))) unsigned gu32_t; typedef __attribute__((address_space(1))) unsigned long long gu64_t;
    static __device__ __forceinline__ float lx(float v, int lane, int o) { return __builtin_bit_cast(float, __builtin_amdgcn_ds_bpermute((lane ^ o) << 2, __builtin_bit_cast(int, v))); }
    __device__ __forceinline__ void wait_cnt(unsigned* c, unsigned want, int lane, PG8_LAS unsigned* flag) const {
        unsigned sp = 0; bool dead = false;
        while ((unsigned)__builtin_amdgcn_readfirstlane(__hip_atomic_load((gu32_t*)c, __ATOMIC_RELAXED, __HIP_MEMORY_SCOPE_AGENT)) < want) {
            __builtin_amdgcn_s_sleep(1);
            if ((++sp & 255u) == 0u) { if (__builtin_amdgcn_readfirstlane(__hip_atomic_load((gu32_t*)tmo, __ATOMIC_RELAXED, __HIP_MEMORY_SCOPE_AGENT))) { dead = true; break; }
                if (sp > (1u << 18)) { if (lane == 0) __hip_atomic_fetch_add((gu32_t*)tmo, 1u, __ATOMIC_RELAXED, __HIP_MEMORY_SCOPE_AGENT); dead = true; break; } } }
        __builtin_amdgcn_fence(__ATOMIC_ACQUIRE, "agent");
        if (lane == 0) flag[0] = dead ? 1u : 0u;
    }
    __device__ __forceinline__ void ldres(u32x2 (&r)[4], int row, int col0) const { const __amdgpu_buffer_rsrc_t rs = wt_rsrc(xb); const unsigned o = (unsigned)(((col0 >> 5) * M + row) * 32 + (col0 & 31)) * 2u;
        const u32x4 a = __builtin_amdgcn_raw_buffer_load_b128(rs, o, 0, 0), b = __builtin_amdgcn_raw_buffer_load_b128(rs, o, 4u * M * 64u, 0);
        r[0] = (u32x2){a.x, a.y}; r[1] = (u32x2){a.z, a.w}; r[2] = (u32x2){b.x, b.y}; r[3] = (u32x2){b.z, b.w}; }
    static __device__ __forceinline__ f32x4 bf4(u32x2 w) { return (f32x4){__uint_as_float(w.x << 16), __uint_as_float(w.x & 0xffff0000u), __uint_as_float(w.y << 16), __uint_as_float(w.y & 0xffff0000u)}; }
    __device__ __forceinline__ void yrow(f32x4& v00, f32x4& v01, f32x4& v10, f32x4& v11, const u32x2 (&r)[4], int col0, int lane, float& mw, float& q) const {
        f32x4 c00 = (f32x4){s, s, s, s}, c01 = c00, c10 = c00, c11 = c00;
        if (colscale) { c00 = *(const f32x4*)(colscale + col0) * s; c01 = *(const f32x4*)(colscale + col0 + 4) * s; c10 = *(const f32x4*)(colscale + col0 + HALF) * s; c11 = *(const f32x4*)(colscale + col0 + HALF + 4) * s; }
        v00 = bf4(r[0]) * ALPHA + v00 * c00; v01 = bf4(r[1]) * ALPHA + v01 * c01; v10 = bf4(r[2]) * ALPHA + v10 * c10; v11 = bf4(r[3]) * ALPHA + v11 * c11;
        float t = ((v00[0] + v00[1]) + (v00[2] + v00[3])) + ((v01[0] + v01[1]) + (v01[2] + v01[3])) + ((v10[0] + v10[1]) + (v10[2] + v10[3])) + ((v11[0] + v11[1]) + (v11[2] + v11[3]));
        t += lx(t, lane, 16); t += lx(t, lane, 32); mw = t * (1.0f / 64.0f);
        const f32x4 d0 = v00 - mw, d1 = v01 - mw, d2 = v10 - mw, d3 = v11 - mw;
        float u = ((d0[0] * d0[0] + d0[1] * d0[1]) + (d0[2] * d0[2] + d0[3] * d0[3])) + ((d1[0] * d1[0] + d1[1] * d1[1]) + (d1[2] * d1[2] + d1[3] * d1[3]))
                + ((d2[0] * d2[0] + d2[1] * d2[1]) + (d2[2] * d2[2] + d2[3] * d2[3])) + ((d3[0] * d3[0] + d3[1] * d3[1]) + (d3[2] * d3[2] + d3[3] * d3[3]));
        u += lx(u, lane, 16); u += lx(u, lane, 32); q = u;
    }
    __device__ __forceinline__ void xrow(const f32x4& v00, const f32x4& v01, const f32x4& v10, const f32x4& v11, int row, int col0, f32x2 sr, const f32x4 (&gg)[4], const f32x4 (&bb)[4]) const {
        const __amdgpu_buffer_rsrc_t rb = wt_rsrc(xb), ro = wt_rsrc(out); const unsigned bo = (unsigned)(((col0 >> 5) * M + row) * 32 + (col0 & 31)) * 2u, oo = (unsigned)(row * DM + col0) * 4u;
        const f32x4 o00 = (v00 - sr.x) * sr.y * gg[0] + bb[0], o01 = (v01 - sr.x) * sr.y * gg[1] + bb[1], o10 = (v10 - sr.x) * sr.y * gg[2] + bb[2], o11 = (v11 - sr.x) * sr.y * gg[3] + bb[3];
        if (out) { __builtin_amdgcn_raw_buffer_store_b128(__builtin_bit_cast(u32x4, o00), ro, oo, 0, 2); __builtin_amdgcn_raw_buffer_store_b128(__builtin_bit_cast(u32x4, o01), ro, oo + 16, 0, 2);
                   __builtin_amdgcn_raw_buffer_store_b128(__builtin_bit_cast(u32x4, o10), ro, oo + HALF * 4, 0, 2); __builtin_amdgcn_raw_buffer_store_b128(__builtin_bit_cast(u32x4, o11), ro, oo + HALF * 4 + 16, 0, 2); }
        else { __builtin_amdgcn_raw_buffer_store_b128(pack8(o00, o01), rb, bo, 0, 0); __builtin_amdgcn_raw_buffer_store_b128(pack8(o10, o11), rb, bo, 4u * M * 64u, 0); }
    }
    __device__ __forceinline__ void exchange(int rows, int row0, int xrow0, int pn, unsigned* counter, unsigned want, PG8_LAS unsigned char* lds, int wid, int lane) const {
        typedef float f32x2v __attribute__((ext_vector_type(2)));
        PG8_LAS f32x2v* P = (PG8_LAS f32x2v*)lds; PG8_LAS f32x2v* S = (PG8_LAS f32x2v*)(lds + 9216); PG8_LAS unsigned* flag = (PG8_LAS unsigned*)(lds + 9216 + 2304);
        asm volatile("s_waitcnt lgkmcnt(0)" ::: "memory"); __builtin_amdgcn_s_barrier(); asm volatile("" ::: "memory");
        const int row = wid * 36 + lane; const bool mine = lane < 36 && row < rows; const size_t grow = (size_t)((row < 256) ? row0 + row : xrow0 + row - 256);
        if (mine) { const f32x2v a = P[row * 4 + 0], b = P[row * 4 + 1], c = P[row * 4 + 2], d = P[row * 4 + 3];
            const float mt = (a.x + b.x + c.x + d.x) * 0.25f; const float da = a.x - mt, db = b.x - mt, dc = c.x - mt, dd = d.x - mt;
            const float m2 = (a.y + b.y) + (c.y + d.y) + 64.0f * ((da * da + db * db) + (dc * dc + dd * dd));
            __hip_atomic_store((gu64_t*)(slots + grow * 8 + pn), ((unsigned long long)__float_as_uint(m2) << 32) | __float_as_uint(mt), __ATOMIC_RELAXED, __HIP_MEMORY_SCOPE_AGENT); }
        asm volatile("s_waitcnt vmcnt(0)" ::: "memory");
        if (lane == 0 && wid * 36 < rows) __hip_atomic_fetch_add((gu32_t*)counter, 1u, __ATOMIC_RELAXED, __HIP_MEMORY_SCOPE_AGENT);
        if (wid == 0) wait_cnt(counter, want, lane, flag);
        asm volatile("s_waitcnt vmcnt(0) lgkmcnt(0)" ::: "memory"); __builtin_amdgcn_s_barrier(); asm volatile("" ::: "memory");
        if (mine) { const unsigned long long* sl = slots + grow * 8; float mt[8], m2[8]; float ms = 0.f;
#pragma unroll
            for (int t = 0; t < 8; ++t) { const unsigned long long w = __hip_atomic_load((gu64_t*)(sl + t), __ATOMIC_RELAXED, __HIP_MEMORY_SCOPE_AGENT); mt[t] = __uint_as_float((unsigned)w); m2[t] = __uint_as_float((unsigned)(w >> 32)); ms += mt[t]; }
            const float mean = ms * 0.125f; float q = 0.f;
#pragma unroll
            for (int t = 0; t < 8; ++t) { const float dm = mt[t] - mean; q += m2[t] + 256.0f * dm * dm; }
            S[row] = (f32x2v){mean, (flag[0] != 0u) ? __builtin_nanf("") : 1.0f / sqrtf(q * (1.0f / DM) + LN_EPS)}; }
        asm volatile("s_waitcnt lgkmcnt(0)" ::: "memory"); __builtin_amdgcn_s_barrier(); asm volatile("" ::: "memory");
    }
    __device__ __forceinline__ void fused_tile(f32x4 (&acc)[2][2][4][2], f32x4 (&accx)[2][2], const Unit& u, int wr, int wc, int fr, int fq, PG8_LAS unsigned char* lds, int wid, int lane) const {
        typedef float f32x2v __attribute__((ext_vector_type(2)));
        PG8_LAS f32x2v* P = (PG8_LAS f32x2v*)lds; const PG8_LAS f32x2v* S = (const PG8_LAS f32x2v*)(lds + 9216);
        const int col0 = u.pn * BM + wc * 32 + 8 * fq, xr0 = MP + 32 * u.pm, xl = 256 + wr * 16 + fr;
        u32x2 rs[9][4];
#pragma unroll
        for (int ai = 0; ai < 2; ++ai)
#pragma unroll
            for (int m = 0; m < 4; ++m) ldres(rs[ai * 4 + m], u.pm * BM + ai * HALF + wr * 64 + m * 16 + fr, col0);
        ldres(rs[8], xr0 + wr * 16 + fr, col0);
#pragma unroll
        for (int ai = 0; ai < 2; ++ai)
#pragma unroll
            for (int m = 0; m < 4; ++m) { const int rl = ai * HALF + wr * 64 + m * 16 + fr; float mw, q;
                yrow(acc[ai][0][m][0], acc[ai][0][m][1], acc[ai][1][m][0], acc[ai][1][m][1], rs[ai * 4 + m], col0, lane, mw, q);
                if (fq == 0) P[rl * 4 + wc] = (f32x2v){mw, q}; }
        { float mw, q; yrow(accx[0][0], accx[0][1], accx[1][0], accx[1][1], rs[8], col0, lane, mw, q); if (fq == 0) P[xl * 4 + wc] = (f32x2v){mw, q}; }
        exchange(288, u.pm * BM, xr0, u.pn, cnt + 64 * u.pm, 64u, lds, wid, lane);
        f32x4 gg[4], bb[4];
        gg[0] = *(const f32x4*)(lng + col0); gg[1] = *(const f32x4*)(lng + col0 + 4); gg[2] = *(const f32x4*)(lng + col0 + HALF); gg[3] = *(const f32x4*)(lng + col0 + HALF + 4);
        bb[0] = *(const f32x4*)(lnb + col0); bb[1] = *(const f32x4*)(lnb + col0 + 4); bb[2] = *(const f32x4*)(lnb + col0 + HALF); bb[3] = *(const f32x4*)(lnb + col0 + HALF + 4);
#pragma unroll
        for (int ai = 0; ai < 2; ++ai)
#pragma unroll
            for (int m = 0; m < 4; ++m) { const int rl = ai * HALF + wr * 64 + m * 16 + fr;
                xrow(acc[ai][0][m][0], acc[ai][0][m][1], acc[ai][1][m][0], acc[ai][1][m][1], u.pm * BM + rl, col0, S[rl], gg, bb); }
        xrow(accx[0][0], accx[0][1], accx[1][0], accx[1][1], xr0 + wr * 16 + fr, col0, S[xl], gg, bb);
    }
    __device__ __forceinline__ void operator()(const f32x4 (&)[2][2][4][2], const Unit&, int, int, int, int) const {}
    __device__ __forceinline__ void grp(f32x4, f32x4, f32x4, f32x4, const Unit&, int, int, int) const {}
};

template <class Epi, class Sched, bool ALIGN_EPI = false, bool SP2 = false, int XMODE = 0  , bool QS = false  >
__device__ __forceinline__ void gemm_phase(PG8_LAS unsigned char* lds, const Gemm g, const Sched& S, const Epi& E, const int tid) {
    constexpr bool XROWS = XMODE != 0;
    static_assert(!XROWS || SP2, "XROWS is written for the two-super-phase loop");
    const int wid = __builtin_amdgcn_readfirstlane(tid >> 6), lane = tid & 63, wr = wid >> 2, wc = wid & 3, fr = lane & 15, fq = lane >> 4;
    const int K = g.K, nt = K / BK;
    unsigned voffA[2], voffB[2];
#pragma unroll
    for (int i = 0; i < 2; ++i) { int R, C; stage_rc(tid * 16 + i * 8192, R, C); const int Rb = Epi::PERM ? ((R & ~31) + perm32(R & 31)) : R;
        voffA[i] = (unsigned)(R * g.lda + C) * 2u; voffB[i] = (unsigned)(Rb * g.ldb + C) * 2u; }
    const __amdgpu_buffer_rsrc_t rsA = __builtin_amdgcn_make_buffer_rsrc((void*)g.A, 0, 0x7fffffff, 0x00020000), rsB = __builtin_amdgcn_make_buffer_rsrc((void*)g.Bt, 0, 0x7fffffff, 0x00020000);
    const unsigned ksa = (unsigned)g.ksa, ksb = (unsigned)g.ksb;
    const __amdgpu_buffer_rsrc_t rsA0 = __builtin_amdgcn_make_buffer_rsrc((void*)g.A, 0, 0, 0x00020000), rsB0 = __builtin_amdgcn_make_buffer_rsrc((void*)g.Bt, 0, 0, 0x00020000);
    const unsigned hstepA = (unsigned)HALF * g.lda * 2, hstepB = (unsigned)HALF * g.ldb * 2;
    const unsigned tstepA = 2 * hstepA, tstepB = 2 * hstepB;
    const unsigned ldsw = (unsigned)wid * 1024u;
    const int aoff = lds_byte(wr * 64 + fr, fq * 8), boff = lds_byte(wc * 32 + fr, fq * 8);
    const unsigned xadj = 0u;
    const int xoff = lds_byte(wr * 16 + fr, fq * 8);
    int xo = STAGE_BYTES + xoff, xst = STAGE_BYTES + 8192;
    constexpr bool BK32 = SP2 && QS && (XMODE != 2) && (PG8_BK32 != 0);
    unsigned voffA1, voffB1, wAo, wBo; const unsigned ldsw2 = (unsigned)wid * 2048u;
    const unsigned khA = (g.lda == 32) ? ksa / 2u : 64u, khB = (g.ldb == 32) ? ksb / 2u : 64u;
    const unsigned xwo = (unsigned)((((wid & 3) >> 1) * 16) * g.lda) * 2u + (unsigned)(wid & 1) * khA + ((wid >= 4) ? ksa : 0u);
    { const int sb = lane * 16, swz = sb ^ (((sb >> 9) & 1) << 5), r = swz >> 6, cb = swz & 63;
      voffA1 = (unsigned)(r * g.lda) * 2u + (unsigned)cb; voffB1 = (unsigned)((Epi::PERM ? (8 * (r >> 2) + (r & 3)) : r) * g.ldb) * 2u + (unsigned)cb;
      wAo = (unsigned)(wid * 16 * g.lda) * 2u; wBo = (unsigned)((Epi::PERM ? (32 * (wid >> 1) + 4 * (wid & 1)) : wid * 16) * g.ldb) * 2u; }
#define Q_ST1(rs, bufoff, soff, voff) __builtin_amdgcn_raw_ptr_buffer_load_lds(rs, (PG8_LAS unsigned*)(lds + (bufoff) + ldsw2), 16, voff, soff, 0, 0)
#define Q_STAGE(b, kh, ta, tb, RSA, RSB) do { Q_ST1(RSA, PG8_SA(b, 0) + (kh) * 1024, (ta) + wAo + (kh) * khA, voffA1); Q_ST1(RSA, PG8_SA(b, 1) + (kh) * 1024, (ta) + hstepA + wAo + (kh) * khA, voffA1); \
        Q_ST1(RSB, PG8_SB(b, 0) + (kh) * 1024, (tb) + wBo + (kh) * khB, voffB1); Q_ST1(RSB, PG8_SB(b, 1) + (kh) * 1024, (tb) + hstepB + wBo + (kh) * khB, voffB1); } while (0)
#define Q_LD(b, kh) do { _Pragma("unroll") for (int ai = 0; ai < 2; ++ai) _Pragma("unroll") for (int m = 0; m < 4; ++m) At[m][ai] = *(const PG8_LAS bf16x8*)(lds + PG8_SA(b, ai) + aoff + m * 2048 + (kh) * 1024); \
        _Pragma("unroll") for (int bj = 0; bj < 2; ++bj) _Pragma("unroll") for (int n = 0; n < 2; ++n) B0[bj][n] = *(const PG8_LAS bf16x8*)(lds + PG8_SB(b, bj) + boff + n * 2048 + (kh) * 1024); } while (0)
#define Q_MMA() do { __builtin_amdgcn_s_setprio(1); _Pragma("unroll") for (int ai = 0; ai < 2; ++ai) _Pragma("unroll") for (int bj = 0; bj < 2; ++bj) _Pragma("unroll") for (int m = 0; m < 4; ++m) _Pragma("unroll") for (int n = 0; n < 2; ++n) \
        acc[ai][bj][m][n] = __builtin_amdgcn_mfma_f32_16x16x32_bf16(B0[bj][n], At[m][ai], acc[ai][bj][m][n], 0, 0, 0); __builtin_amdgcn_s_setprio(0); } while (0)
#define Q_LDX(tb, kh) do { if constexpr (XROWS) Xf[0] = *(const PG8_LAS bf16x8*)(lds + xo + (tb) * 4096 + (kh) * 1024); } while (0)
#define Q_MMAX() do { if constexpr (XROWS) { __builtin_amdgcn_s_setprio(1); _Pragma("unroll") for (int bj = 0; bj < 2; ++bj) _Pragma("unroll") for (int n = 0; n < 2; ++n) \
        accx[bj][n] = __builtin_amdgcn_mfma_f32_16x16x32_bf16(B0[bj][n], Xf[0], accx[bj][n], 0, 0, 0); __builtin_amdgcn_s_setprio(0); __builtin_amdgcn_sched_barrier(0); } } while (0)
#define PG8_XS(b) (STAGE_BYTES + (b) * 8192)
#define PG8_XSTAGE(b, soff) do { if constexpr (XROWS) __builtin_amdgcn_raw_ptr_buffer_load_lds(rsA, (PG8_LAS unsigned*)(lds + PG8_XS(b) + ldsw), 16, voffA1, (soff) + xwo, 0, 0); } while (0)
#define PG8_XSTAGEQ(soff) do { if constexpr (XROWS) __builtin_amdgcn_raw_ptr_buffer_load_lds(rsA2, (PG8_LAS unsigned*)(lds + xst + ldsw), 16, voffA1, (soff) + xwo, 0, 0); } while (0)
#define PG8_LDX(b) do { if constexpr (XROWS) if (XMODE == 1 || hx) { _Pragma("unroll") for (int k = 0; k < 2; ++k) Xf[k] = *(const PG8_LAS bf16x8*)(lds + xo + (b) * 4096 + k * 1024); } } while (0)
#define PG8_MMAX() do { if constexpr (XROWS) { if (XMODE == 1 || hx) { __builtin_amdgcn_s_setprio(1); _Pragma("unroll") for (int k = 0; k < 2; ++k) _Pragma("unroll") for (int n = 0; n < 2; ++n) { \
        accx[0][n] = __builtin_amdgcn_mfma_f32_16x16x32_bf16(B0[n][k], Xf[k], accx[0][n], 0, 0, 0); accx[1][n] = __builtin_amdgcn_mfma_f32_16x16x32_bf16(B1[n][k], Xf[k], accx[1][n], 0, 0, 0); } \
        __builtin_amdgcn_s_setprio(0); } __builtin_amdgcn_sched_barrier(0); } } while (0)
#define PG8_XOFF(u) ((unsigned)(MP + 32 * (u).pm) * (unsigned)(g.lda * 2) + (unsigned)((u).pn / g.grp_tiles) * (unsigned)(g.grp_koff * 2))
#define PG8_SA(b, h) (((b) * 2 + (h)) * HTB)
#define PG8_SB(b, h) ((4 + (b) * 2 + (h)) * HTB)
#define PG8_STAGEX(rs, bufoff, soff, isb) do { Q_ST1(rs, (bufoff), (soff) + ((isb) ? wBo : wAo), ((isb) ? voffB1 : voffA1)); Q_ST1(rs, (bufoff) + 1024, (soff) + ((isb) ? wBo : wAo) + ((isb) ? khB : khA), ((isb) ? voffB1 : voffA1)); } while (0)
#define PG8_STAGE(bufoff, soff, voff, isb) PG8_STAGEX(((isb) ? rsB : rsA), bufoff, soff, isb)
#define PG8_STAGE2(bufoff, soff, voff, isb) PG8_STAGEX(((isb) ? rsB2 : rsA2), bufoff, soff, isb)
#define PG8_LDA(dst, b, h) do { _Pragma("unroll") for (int m = 0; m < 4; ++m) _Pragma("unroll") for (int k = 0; k < 2; ++k) dst[m][k] = *(const PG8_LAS bf16x8*)(lds + PG8_SA(b, h) + aoff + m * 2048 + k * 1024); } while (0)
#define PG8_LDB(dst, b, h) do { _Pragma("unroll") for (int n = 0; n < 2; ++n) _Pragma("unroll") for (int k = 0; k < 2; ++k) dst[n][k] = *(const PG8_LAS bf16x8*)(lds + PG8_SB(b, h) + boff + n * 2048 + k * 1024); } while (0)
#define PG8_MMA(ai, bj, At, Bt) do { __builtin_amdgcn_s_setprio(1); _Pragma("unroll") for (int m = 0; m < 4; ++m) _Pragma("unroll") for (int n = 0; n < 2; ++n) _Pragma("unroll") for (int k = 0; k < 2; ++k) \
        acc[ai][bj][m][n] = __builtin_amdgcn_mfma_f32_16x16x32_bf16(Bt[n][k], At[m][k], acc[ai][bj][m][n], 0, 0, 0); __builtin_amdgcn_s_setprio(0); } while (0)
#define PG8_WAIT_V(n) asm volatile("s_waitcnt vmcnt(" #n ")" ::: "memory")
#define PG8_WAIT_L(n) asm volatile("s_waitcnt lgkmcnt(" #n ")" ::: "memory")
#define PG8_BAR __builtin_amdgcn_s_barrier()
#define PG8_SCHED __builtin_amdgcn_sched_barrier(0)
#define PG8_AOFF(u) ((unsigned)(u).pm * tstepA + (unsigned)((u).pn / g.grp_tiles) * (unsigned)(g.grp_koff * 2))
    Unit cur, nxt; int ui = 0;
    if (!S.next(0, cur)) return;
    f32x4 acc[2][2][4][2];
#pragma unroll
    for (int a = 0; a < 2; ++a)
#pragma unroll
        for (int b = 0; b < 2; ++b)
#pragma unroll
            for (int m = 0; m < 4; ++m)
#pragma unroll
                for (int n = 0; n < 2; ++n) acc[a][b][m][n] = (f32x4){0.f, 0.f, 0.f, 0.f};
    bf16x8 At[4][2], B0[2][2], B1[2][2]; bf16x8 Xf[2]; f32x4 accx[2][2];
#pragma unroll
    for (int b = 0; b < 2; ++b)
#pragma unroll
        for (int n = 0; n < 2; ++n) accx[b][n] = (f32x4){0.f, 0.f, 0.f, 0.f};
    bool hx = false; if constexpr (XMODE == 2) hx = S.hasx(cur);
    unsigned cA = PG8_AOFF(cur), cB = (unsigned)cur.pn * tstepB, cX = (XMODE == 1 || hx) ? PG8_XOFF(cur) : cA + xadj;
    S.a_ready(cur);
    if constexpr (BK32) {
        PG8_XSTAGE(0, cX);
        Q_STAGE(0, 0, cA, cB, rsA, rsB); Q_STAGE(0, 1, cA, cB, rsA, rsB); Q_STAGE(1, 0, cA + ksa, cB + ksb, rsA, rsB);
        if (wr == 1) PG8_BAR;
        PG8_WAIT_V(8);
        PG8_BAR; PG8_BAR;
    } else if constexpr (SP2) {
        PG8_STAGE(PG8_SB(0, 0), cB, voffB, 1); PG8_STAGE(PG8_SB(0, 1), cB + hstepB, voffB, 1); PG8_STAGE(PG8_SA(0, 0), cA, voffA, 0); PG8_STAGE(PG8_SA(0, 1), cA + hstepA, voffA, 0); PG8_XSTAGE(0, cX);
        if (wr == 1) PG8_BAR;
        if constexpr (XROWS) PG8_WAIT_V(3); else PG8_WAIT_V(2);
        PG8_BAR;
        PG8_STAGE(PG8_SB(1, 0), cB + ksb, voffB, 1); PG8_STAGE(PG8_SA(1, 0), cA + ksa, voffA, 0); PG8_STAGE(PG8_SB(1, 1), cB + hstepB + ksb, voffB, 1);
        PG8_WAIT_V(6); PG8_BAR;
        if (PG8_ASYM && wr == 1) { PG8_STAGE(PG8_SA(1, 1), cA + hstepA + ksa, voffA, 0); PG8_XSTAGE(1, cX + ksa); }
    } else {
        PG8_STAGE(PG8_SB(0, 0), cB, voffB, 1); PG8_STAGE(PG8_SA(0, 0), cA, voffA, 0); PG8_STAGE(PG8_SB(0, 1), cB + hstepB, voffB, 1); PG8_STAGE(PG8_SA(0, 1), cA + hstepA, voffA, 0);
        if (wr == 1) PG8_BAR;
        PG8_WAIT_V(4); PG8_BAR;
        PG8_STAGE(PG8_SB(1, 0), cB + ksb, voffB, 1); PG8_STAGE(PG8_SA(1, 0), cA + ksa, voffA, 0); PG8_STAGE(PG8_SB(1, 1), cB + hstepB + ksb, voffB, 1);
        PG8_WAIT_V(6); PG8_BAR;
    }
    for (;;) {
        const bool has_next = S.next(ui + 1, nxt);
        asm volatile("" : "+s"(cA), "+s"(cB), "+s"(cX));
        unsigned nA = has_next ? PG8_AOFF(nxt) : cA, nB = has_next ? (unsigned)nxt.pn * tstepB : cB; bool nhx = false; if constexpr (XMODE == 2) nhx = has_next && S.hasx(nxt);
        unsigned nX = has_next ? ((XMODE == 1 || nhx) ? PG8_XOFF(nxt) : nA + xadj) : cX; asm volatile("" : "+s"(nA), "+s"(nB), "+s"(nX));
        for (int t = 0; t < nt; t += 2) {
            const bool last = (t == nt - 2);
            const unsigned a1 = cA + (unsigned)(t + 1) * ksa;
            const unsigned a2 = last ? nA : cA + (unsigned)(t + 2) * ksa, b2 = last ? nB : cB + (unsigned)(t + 2) * ksb;
            const unsigned a3 = a2 + ksa, b3 = b2 + ksb;
            if (last && has_next) S.a_ready(nxt);
            const bool dry = last && !has_next;
            const __amdgpu_buffer_rsrc_t rsA2 = dry ? rsA0 : rsA, rsB2 = dry ? rsB0 : rsB;
            if constexpr (BK32) {
            const unsigned b1t = cB + (unsigned)(t + 1) * ksb, x2q = last ? nX : cX + (unsigned)(t + 2) * ksa;
            Q_LD(0, 0); Q_LDX(0, 0); PG8_SCHED; Q_STAGE(1, 1, a1, b1t, rsA, rsB);  PG8_WAIT_V(8); PG8_WAIT_L(0); PG8_BAR; Q_MMA(); Q_MMAX(); PG8_SCHED; PG8_BAR; PG8_SCHED;
            Q_LD(0, 1); Q_LDX(0, 1); PG8_SCHED; Q_STAGE(0, 0, a2, b2, rsA2, rsB2); PG8_XSTAGEQ(x2q); if constexpr (XROWS) PG8_WAIT_V(9); else PG8_WAIT_V(8); PG8_WAIT_L(0); PG8_BAR; Q_MMA(); Q_MMAX(); PG8_SCHED; PG8_BAR; PG8_SCHED;
            Q_LD(1, 0); Q_LDX(1, 0); PG8_SCHED; Q_STAGE(0, 1, a2, b2, rsA2, rsB2); if constexpr (XROWS) PG8_WAIT_V(9); else PG8_WAIT_V(8); PG8_WAIT_L(0); PG8_BAR; Q_MMA(); Q_MMAX(); PG8_SCHED; PG8_BAR; PG8_SCHED;
            Q_LD(1, 1); Q_LDX(1, 1); PG8_SCHED; Q_STAGE(1, 0, a3, b3, rsA2, rsB2); PG8_WAIT_V(8); PG8_WAIT_L(0); PG8_BAR; Q_MMA(); Q_MMAX(); PG8_SCHED; PG8_BAR; PG8_SCHED;
            xo ^= 8192; xst ^= 8192;
            } else if constexpr (SP2) {
#define PG8_WAIT_SPA() PG8_WAIT_V(8)
#define PG8_WAIT_SPB() do { if constexpr (XROWS) PG8_WAIT_V(9); else PG8_WAIT_V(8); } while (0)
            const unsigned x1 = cX + (unsigned)(t + 1) * ksa, x2 = last ? nX : cX + (unsigned)(t + 2) * ksa, x3 = x2 + ksa;
            const bool WL = PG8_ASYM && (wr == 0), IE = PG8_ASYM && (wr == 1);
            PG8_LDB(B0, 0, 0); PG8_LDB(B1, 0, 1); PG8_SCHED; PG8_LDA(At, 0, 0); if (!IE) { PG8_STAGE(PG8_SA(1, 1), a1 + hstepA, voffA, 0); }
            if (!WL) PG8_WAIT_SPA(); PG8_WAIT_L(0); PG8_BAR;
            if (IE) { PG8_STAGE2(PG8_SB(0, 0), b2, voffB, 1); PG8_STAGE2(PG8_SB(0, 1), b2 + hstepB, voffB, 1); PG8_STAGE2(PG8_SA(0, 0), a2, voffA, 0); }
            PG8_MMA(0, 0, At, B0); PG8_MMA(0, 1, At, B1); PG8_SCHED; if (WL) PG8_WAIT_SPA(); PG8_BAR; PG8_SCHED;
            PG8_LDA(At, 0, 1); PG8_LDX(0); if (!IE) { PG8_STAGE2(PG8_SB(0, 0), b2, voffB, 1); PG8_STAGE2(PG8_SB(0, 1), b2 + hstepB, voffB, 1); PG8_STAGE2(PG8_SA(0, 0), a2, voffA, 0); }
            if (!WL) PG8_WAIT_SPA(); PG8_WAIT_L(0); PG8_BAR;
            if (IE) { PG8_STAGE2(PG8_SA(0, 1), a2 + hstepA, voffA, 0); PG8_XSTAGE(0, x2); }
            PG8_MMA(1, 0, At, B0); PG8_MMA(1, 1, At, B1); PG8_MMAX(); PG8_SCHED; if (WL) PG8_WAIT_SPA(); PG8_BAR; PG8_SCHED;
            PG8_LDB(B0, 1, 0); PG8_LDB(B1, 1, 1); PG8_SCHED; PG8_LDA(At, 1, 0); if (!IE) { PG8_STAGE2(PG8_SA(0, 1), a2 + hstepA, voffA, 0); PG8_XSTAGEQ(x2); }
            if (!WL) PG8_WAIT_SPB(); PG8_WAIT_L(0); PG8_BAR;
            if (IE) { PG8_STAGE2(PG8_SB(1, 0), b3, voffB, 1); PG8_STAGE2(PG8_SB(1, 1), b3 + hstepB, voffB, 1); PG8_STAGE2(PG8_SA(1, 0), a3, voffA, 0); }
            PG8_MMA(0, 0, At, B0); PG8_MMA(0, 1, At, B1); PG8_SCHED; if (WL) PG8_WAIT_SPB(); PG8_BAR; PG8_SCHED;
            PG8_LDA(At, 1, 1); PG8_LDX(1); if (!IE) { PG8_STAGE2(PG8_SB(1, 0), b3, voffB, 1); PG8_STAGE2(PG8_SB(1, 1), b3 + hstepB, voffB, 1); PG8_STAGE2(PG8_SA(1, 0), a3, voffA, 0); }
            if (!WL) PG8_WAIT_SPB(); PG8_WAIT_L(0); PG8_BAR;
            if (IE) { PG8_STAGE2(PG8_SA(1, 1), a3 + hstepA, voffA, 0); PG8_XSTAGE(1, x3); }
            PG8_MMA(1, 0, At, B0); PG8_MMA(1, 1, At, B1); PG8_MMAX(); PG8_SCHED; if (WL) PG8_WAIT_SPB(); PG8_BAR; PG8_SCHED;
            xo ^= 8192; xst ^= 8192;
#undef PG8_WAIT_SPA
#undef PG8_WAIT_SPB
            } else {
            PG8_LDB(B0, 0, 0); PG8_SCHED; PG8_LDA(At, 0, 0); PG8_STAGE(PG8_SA(1, 1), a1 + hstepA, voffA, 0);
            PG8_WAIT_L(8); PG8_BAR; PG8_WAIT_L(0); PG8_MMA(0, 0, At, B0); PG8_BAR; PG8_SCHED;
            PG8_LDB(B1, 0, 1); PG8_STAGE(PG8_SB(0, 0), b2, voffB, 1);
            PG8_BAR; PG8_WAIT_L(0); PG8_MMA(0, 1, At, B1); PG8_BAR;
            PG8_LDA(At, 0, 1); PG8_STAGE(PG8_SA(0, 0), a2, voffA, 0);
            PG8_BAR; PG8_WAIT_L(0); PG8_MMA(1, 0, At, B0); PG8_BAR; PG8_SCHED;
            PG8_STAGE(PG8_SB(0, 1), b2 + hstepB, voffB, 1);
            PG8_WAIT_V(6); PG8_BAR; PG8_MMA(1, 1, At, B1); PG8_BAR;
            PG8_LDB(B0, 1, 0); PG8_SCHED; PG8_LDA(At, 1, 0); PG8_STAGE(PG8_SA(0, 1), a2 + hstepA, voffA, 0);
            PG8_WAIT_L(8); PG8_BAR; PG8_WAIT_L(0); PG8_MMA(0, 0, At, B0); PG8_BAR; PG8_SCHED;
            PG8_LDB(B1, 1, 1); PG8_STAGE(PG8_SB(1, 0), b3, voffB, 1);
            PG8_BAR; PG8_WAIT_L(0); PG8_MMA(0, 1, At, B1); PG8_BAR;
            PG8_LDA(At, 1, 1); PG8_STAGE(PG8_SA(1, 0), a3, voffA, 0);
            PG8_BAR; PG8_WAIT_L(0); PG8_MMA(1, 0, At, B0); PG8_BAR; PG8_SCHED;
            PG8_STAGE(PG8_SB(1, 1), b3 + hstepB, voffB, 1);
            PG8_WAIT_V(6); PG8_BAR; PG8_MMA(1, 1, At, B1); PG8_BAR;
            }
        }
        if constexpr (ALIGN_EPI) { if (wr == 0) PG8_BAR; }
        if constexpr (!Epi::AFTER_DRAIN) { int el = lane; asm volatile("" : "+v"(el)); const int efr = el & 15, efq = el >> 4;
            E(acc, cur, wr, wc, efr, efq);
            if constexpr (XROWS) if (XMODE == 1 || hx) E.grp(accx[0][0], accx[0][1], accx[1][0], accx[1][1], cur, MP + 32 * cur.pm + wr * 16 + efr, wc, efq); }
        if (!has_next) break;
#pragma unroll
        for (int a = 0; a < 2; ++a)
#pragma unroll
            for (int b = 0; b < 2; ++b)
#pragma unroll
                for (int m = 0; m < 4; ++m)
#pragma unroll
                    for (int n = 0; n < 2; ++n) acc[a][b][m][n] = (f32x4){0.f, 0.f, 0.f, 0.f};
        if constexpr (XROWS) {
#pragma unroll
            for (int b = 0; b < 2; ++b)
#pragma unroll
                for (int n = 0; n < 2; ++n) accx[b][n] = (f32x4){0.f, 0.f, 0.f, 0.f}; }
        cur = nxt; cA = nA; cB = nB; cX = nX; hx = nhx; ++ui;
        if constexpr (ALIGN_EPI) { if (wr == 1) PG8_BAR; }
    }
    PG8_WAIT_V(0);
    if constexpr (!ALIGN_EPI) { if (wr == 0) PG8_BAR; }
    PG8_BAR;
    if constexpr (Epi::AFTER_DRAIN) E.fused_tile(acc, accx, cur, wr, wc, fr, fq, lds, wid, lane);
#undef PG8_SA
#undef PG8_SB
#undef PG8_LDA
#undef PG8_LDB
#undef PG8_MMA
#undef PG8_XS
#undef PG8_XSTAGE
#undef PG8_LDX
#undef PG8_MMAX
#undef PG8_XOFF
}

template <class Epi, class Sched>
__device__ __forceinline__ void gemm_sub_phase(PG8_LAS unsigned char* lds, const Gemm g, const Sched& S, const Epi& E, const int tid) {
    const int wid = __builtin_amdgcn_readfirstlane(tid >> 6), lane = tid & 63, wm = wid >> 2, wc = wid & 3, fr = lane & 15, fq = lane >> 4;
    const int nt = g.K / BK;
    unsigned voffA, voffB[2];
    { int R, C; stage_rc((tid & 255) * 16, R, C); voffA = (unsigned)(R * g.lda + C) * 2u; }
#pragma unroll
    for (int i = 0; i < 2; ++i) { int R, C; stage_rc(tid * 16 + i * 8192, R, C); const int Rb = Epi::PERM ? ((R & ~31) + perm32(R & 31)) : R; voffB[i] = (unsigned)(Rb * g.ldb + C) * 2u; }
    const size_t ksa = (size_t)g.ksa, ksb = (size_t)g.ksb, hstepB = (size_t)HALF * g.ldb * 2;
    const unsigned ldsw = (unsigned)wid * 1024u;
    const int aoff = lds_byte(wm * 16 + fr, fq * 8), boff = 4096 + lds_byte(wc * 32 + fr, fq * 8);
    constexpr int SS = 36864;
    const bool lda_wave = wid < 4;
#define PG8_SUBSTAGE(so, kt) do { const char* _a = gA + (size_t)(kt) * ksa; const char* _b = gB + (size_t)(kt) * ksb; \
        if (lda_wave) __builtin_amdgcn_global_load_lds((const unsigned*)(_a + voffA), (PG8_LAS unsigned*)(lds + (so) + ldsw), 16, 0, 0); \
        _Pragma("unroll") for (int _h = 0; _h < 2; ++_h) _Pragma("unroll") for (int _i = 0; _i < 2; ++_i) \
            __builtin_amdgcn_global_load_lds((const unsigned*)(_b + _h * hstepB + voffB[_i]), (PG8_LAS unsigned*)(lds + (so) + 4096 + _h * 16384 + _i * 8192 + ldsw), 16, 0, 0); } while (0)
    Unit u; int sub;
    for (int i = 0; S.next_sub(i, u, sub); ++i) {
        const char* gA = (const char*)g.A + ((size_t)u.pm * BM + sub * 32) * g.lda * 2 + (size_t)(u.pn / g.grp_tiles) * (size_t)g.grp_koff * 2;
        const char* gB = (const char*)g.Bt + (size_t)u.pn * BM * g.ldb * 2;
        f32x4 acc[2][2];
#pragma unroll
        for (int b = 0; b < 2; ++b)
#pragma unroll
            for (int n = 0; n < 2; ++n) acc[b][n] = (f32x4){0.f, 0.f, 0.f, 0.f};
        int s0 = 0, s1 = SS, s2 = 2 * SS, s3 = 3 * SS;
        PG8_SUBSTAGE(s0, 0); PG8_SUBSTAGE(s1, 1); PG8_SUBSTAGE(s2, (nt > 2 ? 2 : nt - 1));
        for (int t = 0; t < nt; ++t) {
            if (lda_wave) PG8_WAIT_V(10); else PG8_WAIT_V(8);
            PG8_BAR;
            const int tn = (t + 3 < nt) ? t + 3 : nt - 1;
            PG8_SUBSTAGE(s3, tn);
            bf16x8 Af[2], Bf[2][2][2];
#pragma unroll
            for (int k = 0; k < 2; ++k) Af[k] = *(const PG8_LAS bf16x8*)(lds + s0 + aoff + k * 1024);
#pragma unroll
            for (int b = 0; b < 2; ++b)
#pragma unroll
                for (int n = 0; n < 2; ++n)
#pragma unroll
                    for (int k = 0; k < 2; ++k) Bf[b][n][k] = *(const PG8_LAS bf16x8*)(lds + s0 + boff + b * 16384 + n * 2048 + k * 1024);
#pragma unroll
            for (int k = 0; k < 2; ++k)
#pragma unroll
                for (int b = 0; b < 2; ++b)
#pragma unroll
                    for (int n = 0; n < 2; ++n) acc[b][n] = __builtin_amdgcn_mfma_f32_16x16x32_bf16(Bf[b][n][k], Af[k], acc[b][n], 0, 0, 0);
            const int st = s0; s0 = s1; s1 = s2; s2 = s3; s3 = st;
        }
        PG8_WAIT_V(0); PG8_BAR;
        E.grp(acc[0][0], acc[0][1], acc[1][0], acc[1][1], u, u.pm * BM + sub * 32 + wm * 16 + fr, wc, fq);
    }
#undef PG8_SUBSTAGE
#undef PG8_AOFF
#undef PG8_STAGE
#undef PG8_WAIT_V
#undef PG8_WAIT_L
#undef PG8_BAR
#undef PG8_SCHED
}
}

constexpr size_t MiB = 1u << 20;
constexpr size_t WS_CTL = 0, CTL_ZERO_BYTES = 1 * MiB;
constexpr size_t SZ_WGU = (size_t)2 * DFF * LDK * 2, SZ_WD = (size_t)DM * DFF * 2;
constexpr size_t WS_WGU = 2 * MiB, WS_WD = WS_WGU + 8 * SZ_WGU;
constexpr size_t WS_AIN = WS_WD + 8 * SZ_WD, WS_AOUT = WS_AIN + 2 * (size_t)4096 * LDK * 2, WS_BGRP = WS_AOUT + 2 * (size_t)DM * LDK * 2,
                 WS_CIN = WS_BGRP + (size_t)DM * 512 * 2, WS_COUT = WS_CIN + (size_t)6144 * LDK * 2, WS_WEND = WS_COUT + (size_t)DM * LDK * 2;
constexpr size_t WS_XB = (WS_WEND + MiB - 1) / MiB * MiB;
constexpr size_t WS_ACT = WS_XB + (size_t)M * LDK * 2;
constexpr size_t WS_UV = WS_ACT + (size_t)M * DFF * 2;
constexpr size_t WS_T1 = WS_UV + (size_t)M * 4096 * 2;
constexpr size_t WS_T2 = WS_T1 + (size_t)M * LDK * 2;
constexpr size_t WS_PART = WS_T2 + (size_t)M * LDK * 2;
constexpr size_t WS_SLOT = WS_PART + (size_t)M * DM * 4;
constexpr size_t WS_VST = WS_SLOT + (size_t)M * 8 * 8;
constexpr size_t WS_END = WS_VST + (size_t)2 * M * 32 * 2 * 4;
constexpr int CW_BAR = 4096, CW_TMO = 0, CW_LN = 16384, LN_BANK = 128 * 64, CW_FLAG = 65536;

constexpr int RING_OFF = 0, RING_BYTES = 147456;
constexpr int LDSCTL_OFF = RING_BYTES, MISC_OFF = LDSCTL_OFF + 320;
constexpr int LDS_BYTES = 151552;
constexpr int NWAVES = 8;

#define GAS __attribute__((address_space(1)))
#define LAS __attribute__((address_space(3)))
typedef unsigned short bf16;
typedef unsigned v4u __attribute__((ext_vector_type(4)));
typedef unsigned v2u __attribute__((ext_vector_type(2)));
typedef float f32x4 __attribute__((ext_vector_type(4)));
typedef short bf16x8 __attribute__((ext_vector_type(8)));
typedef short s16x4 __attribute__((ext_vector_type(4)));
typedef float f32x2v __attribute__((ext_vector_type(2)));
#define LDS_WAIT() asm volatile("s_waitcnt lgkmcnt(0)" ::: "memory")
#define VM_WAIT() asm volatile("s_waitcnt vmcnt(0)" ::: "memory")
__device__ __forceinline__ int opaque_tid(int wave_id) { int l; asm volatile("v_mbcnt_lo_u32_b32 %0, -1, 0\n\tv_mbcnt_hi_u32_b32 %0, -1, %0" : "=v"(l)); return wave_id * 64 + l; }
__device__ __forceinline__ unsigned pk2(float lo, float hi) { return pg8::cvt_pk_bf16(lo, hi); }
__device__ __forceinline__ float bflo(unsigned u) { return __builtin_bit_cast(float, u << 16); }
__device__ __forceinline__ float bfhi(unsigned u) { return __builtin_bit_cast(float, u & 0xffff0000u); }

#define XB_TMO      128
#define XB_XCNT(j)  (256  + 64 * (j))
#define XB_XSUB(j)  (1280 + 64 * (j))
#define XB_XGEN(j)  (2304 + 64 * (j))
#define XB_TOP      3328
#define XB_TOPGEN   3392
#define XCD_BAR_WORDS 3456
#define XB_SPIN_CAP (1u << 18)
__device__ __forceinline__ unsigned xb_ld(unsigned* p)              { return __hip_atomic_load((GAS unsigned*)p, __ATOMIC_RELAXED, __HIP_MEMORY_SCOPE_AGENT); }
__device__ __forceinline__ unsigned xb_add(unsigned* p, unsigned v) { return __hip_atomic_fetch_add((GAS unsigned*)p, v, __ATOMIC_RELAXED, __HIP_MEMORY_SCOPE_AGENT); }
__device__ __forceinline__ unsigned xb_xcc_id() { return (unsigned)__builtin_amdgcn_s_getreg((3 << 11) | 20) & 0xFu; }
#define XB_SPIN(cond, bar) do { unsigned _sp = 0; while (cond) { __builtin_amdgcn_s_sleep(1); \
    if ((++_sp & 255u) == 0u) { if (xb_ld(&(bar)[XB_TMO])) break; if (_sp > XB_SPIN_CAP) { xb_add(&(bar)[XB_TMO], 1u); break; } } } } while (0)
struct XcdBarrier { unsigned* bar; unsigned x; volatile LAS unsigned* st; };
__device__ __forceinline__ XcdBarrier xcd_barrier_post(unsigned* bar, volatile LAS unsigned* st, int tid) {
    XcdBarrier b; b.bar = bar; b.x = xb_xcc_id(); b.st = st;
    if (tid == 0) (void)xb_add(&bar[XB_XCNT(b.x)], 1u);
    return b;
}
__device__ __forceinline__ void xcd_barrier_complete(unsigned* bar, unsigned x, unsigned& nloc, unsigned& nx) {
    const unsigned G = gridDim.x * gridDim.y * gridDim.z;
    unsigned sum, cnt, mine, sp = 0u;
    for (;;) {
        sum = 0u; cnt = 0u; mine = 0u;
#pragma unroll
        for (unsigned j = 0; j < 16; ++j) { const unsigned c = xb_ld(&bar[XB_XCNT(j)]); sum += c; cnt += (c > 0u) ? 1u : 0u; mine = (j == x) ? c : mine; }
        if (sum == G) break;
        __builtin_amdgcn_s_sleep(1);
        if ((++sp & 255u) == 0u) { if (xb_ld(&bar[XB_TMO])) break; if (sp > XB_SPIN_CAP) { xb_add(&bar[XB_TMO], 1u); break; } }
    }
    nloc = mine > 0u ? mine : 1u; nx = cnt > 0u ? cnt : 1u;
}
__device__ __forceinline__ void xcd_barrier(const XcdBarrier& b, int tid) {
    asm volatile("s_waitcnt vmcnt(0)" ::: "memory");
    __syncthreads();
    if (tid == 0) {
        unsigned* bar = b.bar; asm volatile("" : "+s"(bar)); bar = (unsigned*)(GAS unsigned*)bar;
        __builtin_amdgcn_s_waitcnt(0);
        unsigned nloc = b.st[0], nx = b.st[1];
        if (nloc == 0u) { xcd_barrier_complete(bar, b.x, nloc, nx); b.st[0] = nloc; b.st[1] = nx; }
        const unsigned old = xb_add(&bar[XB_XSUB(b.x)], 1u);
        const unsigned gen = old / nloc;
        if (old + 1u == (gen + 1u) * nloc) {
            __builtin_amdgcn_fence(__ATOMIC_RELEASE, "agent");
            asm volatile("s_waitcnt vmcnt(0)" ::: "memory");
            const unsigned og = xb_add(&bar[XB_TOP], 1u);
            const unsigned tg = og / nx;
            if (og + 1u == (tg + 1u) * nx) xb_add(&bar[XB_TOPGEN], 1u);
            else XB_SPIN(xb_ld(&bar[XB_TOPGEN]) == tg, bar);
            __builtin_amdgcn_fence(__ATOMIC_ACQUIRE, "agent");
            xb_add(&bar[XB_XGEN(b.x)], 1u);
            asm volatile("s_waitcnt vmcnt(0)" ::: "memory");
        } else {
            XB_SPIN(xb_ld(&bar[XB_XGEN(b.x)]) == gen, bar);
            __builtin_amdgcn_fence(__ATOMIC_ACQUIRE, "agent");
            asm volatile("s_waitcnt vmcnt(0)" ::: "memory");
        }
    }
    __syncthreads();
}

__device__ __forceinline__ float wave_sum(float v, int lane) {
#pragma unroll
    for (int o = 1; o < 64; o <<= 1) v += __builtin_bit_cast(float, __builtin_amdgcn_ds_bpermute((lane ^ o) << 2, __builtin_bit_cast(int, v)));
    return v;
}
__device__ __forceinline__ void p0_transpose_item(const float* W, int N, bf16* WT, int ldk, int k0, int n0, int drow0, LAS float* scr, int lane, int km_rows = 0  , int k32 = 0  ) {
#pragma unroll 8
    for (int i = 0; i < 32; ++i) { const int kk = 2 * i + (lane >> 5); scr[kk * 33 + (lane & 31)] = __builtin_nontemporal_load(W + (size_t)(k0 + kk) * N + n0 + (lane & 31)); }
    LDS_WAIT(); asm volatile("" ::: "memory");
    const int c = lane & 7;
#pragma unroll
    for (int j = 0; j < 4; ++j) { const int n = (lane >> 3) + 8 * j; const LAS float* s = scr + (8 * c) * 33 + n;
        v4u o; o.x = pk2(s[0 * 33], s[1 * 33]); o.y = pk2(s[2 * 33], s[3 * 33]); o.z = pk2(s[4 * 33], s[5 * 33]); o.w = pk2(s[6 * 33], s[7 * 33]);
        if (k32) __builtin_nontemporal_store(o, (v4u*)(WT + ((size_t)((k0 >> 5) + (c >> 2)) * km_rows + drow0 + n) * 32 + 8 * (c & 3)));
        else if (km_rows) __builtin_nontemporal_store(o, (v4u*)(WT + ((size_t)(k0 >> 6) * km_rows + drow0 + n) * 64 + 8 * c)); else __builtin_nontemporal_store(o, (v4u*)(WT + (size_t)(drow0 + n) * ldk + k0 + 8 * c)); }
    LDS_WAIT(); asm volatile("" ::: "memory");
}

__device__ __forceinline__ size_t xb_idx(int m, int c) { return ((size_t)(c >> 5) * M + (size_t)m) * 32 + (size_t)(c & 31); }

struct Args { const float* in[25]; float* out; unsigned char* ws; int ph_lo, ph_hi; };

__global__ void __launch_bounds__(NWAVES * 64, 2) fwd_kernel(Args args) {
    extern __shared__ __attribute__((aligned(16))) unsigned char lds_raw[];
    LAS unsigned char* lds = (LAS unsigned char*)lds_raw;
    volatile LAS unsigned* MISC = (volatile LAS unsigned*)(lds + MISC_OFF);
    const int G = gridDim.x; const int bx = blockIdx.x;
    const int wave_id = __builtin_amdgcn_readfirstlane((int)threadIdx.x >> 6);
    const int vcu = (G % 8 == 0) ? (bx % 8) * (G / 8) + bx / 8 : bx;
    const int NGW = G * NWAVES;
#define PH_IDS() const int tid = opaque_tid(wave_id), lane = tid & 63, wave = __builtin_amdgcn_readfirstlane(tid >> 6), gw = vcu * NWAVES + wave; (void)lane; (void)gw
#define INP(i) ((const float*)(const GAS float*)ap->in[i])
#define PH_PTRS() const __attribute__((address_space(4))) Args* ap = (const __attribute__((address_space(4))) Args*)__builtin_amdgcn_kernarg_segment_ptr(); asm volatile("" : "+s"(ap)); \
    unsigned char* const ws = (unsigned char*)(GAS unsigned char*)ap->ws; unsigned* const ctl = (unsigned*)(ws + WS_CTL); float* const OUT = (float*)(GAS float*)ap->out; float* const X = OUT + OFF_Y; \
    bf16* const XB = (bf16*)(ws + WS_XB); bf16* const ACT = (bf16*)(ws + WS_ACT); bf16* const UV = (bf16*)(ws + WS_UV); bf16* const T1 = (bf16*)(ws + WS_T1); bf16* const T2 = (bf16*)(ws + WS_T2); \
    (void)ctl; (void)X; (void)XB; (void)ACT; (void)UV; (void)T1; (void)T2
    for (int u = threadIdx.x; u < (LDS_BYTES - LDSCTL_OFF) / 4; u += NWAVES * 64) ((LAS unsigned*)(lds + LDSCTL_OFF))[u] = 0u;
    __syncthreads();
    XcdBarrier bar; bar.bar = (unsigned*)(args.ws + WS_CTL) + CW_BAR; bar.x = 0; bar.st = nullptr;
    if (!MK_PER_PHASE) bar = xcd_barrier_post((unsigned*)(args.ws + WS_CTL) + CW_BAR, MISC + 8, (int)threadIdx.x);

    const int lo = args.ph_lo, hi = args.ph_hi;
    int ph = 0;
#define PH_ON() (lo <= ph && ph < hi)
#define PH_END() do { if (!MK_PER_PHASE && (ph + 1) < hi) for (int _r = 0; _r < REP_BAR; ++_r) xcd_barrier(bar, opaque_tid(wave_id)); ++ph; } while (0)

    if (PH_ON()) {
        PH_IDS(); PH_PTRS();
        LAS float* scr = (LAS float*)(lds + RING_OFF + wave * 16384);
        constexpr int I_GU = 32 * 344, I_D = 86 * 64, I_AIN = 32 * 128, I_SQ = 32 * 64, I_BG = 8 * 16, I_CIN = 32 * 192;
        constexpr int E0 = 4 * I_GU, E1 = E0 + 4 * I_D, E2 = E1 + 4 * I_GU, E3 = E2 + 4 * I_D, E4 = E3 + 2 * I_AIN, E5 = E4 + 2 * I_SQ, E6 = E5 + 4 * I_BG, E7 = E6 + I_CIN, E8 = E7 + I_SQ;
        for (int rep = 0; rep < REP_PRO; ++rep)
        for (int it = gw; it < E8; it += NGW) {
            if (it < E3) {
                const int which = (it >= E1) ? 1 : 0; int r = it - (which ? E1 : 0);
                if (r < E0) { const int mat = r / I_GU, q = r % I_GU, kb = q / 344, nb = q % 344, n0 = nb * 32;
                    const int nn = (n0 < DFF) ? n0 : n0 - DFF, drow0 = 256 * (nn >> 7) + (nn & 127) + ((n0 < DFF) ? 0 : 128);
                    p0_transpose_item(INP(which ? 6 : 4) + (size_t)mat * DM * 2 * DFF, 2 * DFF, (bf16*)(ws + WS_WGU + (size_t)(2 * mat + which) * SZ_WGU), LDK, kb * 64, n0, drow0, scr, lane, 2 * DFF, 1); }
                else { r -= E0; const int mat = r / I_D, q = r % I_D, kb = q / 64, nb = q % 64;
                    p0_transpose_item(INP(which ? 7 : 5) + (size_t)mat * DFF * DM, DM, (bf16*)(ws + WS_WD + (size_t)(2 * mat + which) * SZ_WD), DFF, kb * 64, nb * 32, nb * 32, scr, lane, DM, 1); }
            } else if (it < E4) { const int r = it - E3, mat = r / I_AIN, q = r % I_AIN, kb = q / 128, nb = q % 128;
                p0_transpose_item(INP(14) + (size_t)mat * DM * 4096, 4096, (bf16*)(ws + WS_AIN) + (size_t)mat * 4096 * LDK, LDK, kb * 64, nb * 32, nb * 32, scr, lane, 4096, 1);
            } else if (it < E5) { const int r = it - E4, mat = r / I_SQ, q = r % I_SQ, kb = q / 64, nb = q % 64;
                p0_transpose_item(INP(19) + (size_t)mat * DM * DM, DM, (bf16*)(ws + WS_AOUT) + (size_t)mat * DM * LDK, LDK, kb * 64, nb * 32, nb * 32, scr, lane);
            } else if (it < E6) { const int r = it - E5, mat = r / I_BG, q = r % I_BG, kb = q / 16, nb = q % 16;
                p0_transpose_item(INP(20) + (size_t)mat * 512 * 512, 512, (bf16*)(ws + WS_BGRP), 512, kb * 64, nb * 32, mat * 512 + nb * 32, scr, lane);
            } else if (it < E7) { const int r = it - E6, kb = r / 192, nb = r % 192, n0 = nb * 32;
                int drow0; if (n0 < 2048) drow0 = n0; else { const int nn = (n0 < 4096) ? n0 - 2048 : n0 - 4096; drow0 = 2048 + 256 * (nn >> 7) + (nn & 127) + ((n0 < 4096) ? 0 : 128); }
                p0_transpose_item(INP(22), 6144, (bf16*)(ws + WS_CIN), LDK, kb * 64, n0, drow0, scr, lane, 6144, 1);
            } else { const int r = it - E7, kb = r / 64, nb = r % 64;
                p0_transpose_item(INP(24), DM, (bf16*)(ws + WS_COUT), LDK, kb * 64, nb * 32, nb * 32, scr, lane); }
        }
        for (int m = gw; m < M; m += NGW) {
            const float* src = (m < MP) ? INP(0) + (size_t)m * DM : INP(1) + (size_t)(m - MP) * DM;
            const f32x4* xr = (const f32x4*)src + lane;
#pragma unroll
            for (int j = 0; j < 8; ++j) { const f32x4 v = __builtin_nontemporal_load(xr + 64 * j); v2u w; w.x = pk2(v.x, v.y); w.y = pk2(v.z, v.w); *(v2u*)(XB + xb_idx(m, 4 * (lane + 64 * j))) = w; }
        }
    }
    PH_END();

    for (int step = 0; step < 12; ++step) {
        const int L = step / 3, sub = step % 3, kind = L % 3, jm = L / 3;
        size_t og_a, og_b; int og_lda = LDK, og_ldb = LDK, og_K = DM, og_gt = 1 << 20, og_gk = 0, ocs_on = 0; long og_ksa = 128, og_ksb = 128; float os = 1.f;
        if (sub != 1) {
            const int hs = 2 * L + (sub == 2 ? 1 : 0);
            if (PH_ON()) {
                PH_PTRS();
                pg8::Gemm g{XB, (const bf16*)(ws + WS_WGU + (size_t)hs * SZ_WGU), 32, 32, DM, 1 << 20, 0, (long)M * 128, (long)2 * DFF * 128}; pg8::UpOrder S0{bx, 0}, S1{bx, 1};
                pg8::EpiSwiGLU E{ACT, DFF};
                for (int rep = 0; rep < REP_UP; ++rep, (rep < REP_UP ? xcd_barrier(bar, opaque_tid(wave_id)) : (void)0))
                { pg8::gemm_phase<pg8::EpiSwiGLU, pg8::UpOrder, true, true, 0, true>(lds + RING_OFF, g, S0, E, opaque_tid(wave_id)); pg8::gemm_phase<pg8::EpiSwiGLU, pg8::UpOrder, true, true, 1, true>(lds + RING_OFF, g, S1, E, opaque_tid(wave_id)); }
            }
            PH_END();
            og_a = WS_ACT; og_b = WS_WD + (size_t)hs * SZ_WD; og_lda = 32; og_ldb = 32; og_K = DFF; os = 0.5f; og_ksa = (long)M * 128; og_ksb = (long)DM * 128;
        } else if (kind == 0) {
            if (PH_ON()) {
                PH_PTRS();
                pg8::Gemm g{XB, (const bf16*)(ws + WS_AIN) + (size_t)jm * 4096 * LDK, 32, 32, DM, 1 << 20, 0, (long)M * 128, (long)4096 * 128}; pg8::DpOrder S; S.init(MP / 256, 16, G, bx, false);
                pg8::EpiBf16<1> E{UV, 4096, (float*)(ws + WS_VST) + (size_t)jm * M * 64};
                for (int rep = 0; rep < REP_MG; ++rep)
                pg8::gemm_phase<pg8::EpiBf16<1>, pg8::DpOrder, true, true, 1, true>(lds + RING_OFF, g, S, E, opaque_tid(wave_id));
            }
            PH_END();
            if (PH_ON()) {
                PH_IDS(); PH_PTRS();
                const float* WSm = INP(17) + (size_t)jm * 16 * 128 * 128; const float* BSm = INP(18) + (size_t)jm * 16 * 128;
                const float* lg = INP(15) + (size_t)jm * DM; const float* lb = INP(16) + (size_t)jm * DM; const float* VST = (const float*)(ws + WS_VST) + (size_t)jm * M * 64;
                LAS f32x2v* ST = (LAS f32x2v*)(lds + 40960);
                constexpr int VS = 272;
                const int fr = lane & 15, fq = lane >> 4;
                for (int rep = 0; rep < REP_MIX; ++rep) {
                for (int item = bx; item < 64 * 16; item += G) {
                    const int chunk = item >> 4, h = item & 15;
                    const int sr = tid >> 2, part = tid & 3; const f32x2v* ps = (const f32x2v*)(VST + (((size_t)chunk * 128 + sr) * 32 + part * 8) * 2);
                    f32x2v pp[8];
#pragma unroll
                    for (int k = 0; k < 8; ++k) pp[k] = ps[k];
                    const int ch = tid & 15, cb = h * 128 + ch * 8;
                    v4u vraw[4];
#pragma unroll
                    for (int i = 0; i < 4; ++i) vraw[i] = *(const v4u*)(UV + ((size_t)chunk * 128 + (tid >> 4) + 32 * i) * 4096 + 2048 + cb);
                    const f32x4 g0 = *(const f32x4*)(lg + cb), g1 = *(const f32x4*)(lg + cb + 4), b0 = *(const f32x4*)(lb + cb), b1 = *(const f32x4*)(lb + cb + 4);
                    const int t0 = 16 * wave, nks = (wave >> 1) + 1, trow = t0 + fr;
                    f32x4 wreg[4][2];
#pragma unroll
                    for (int ks = 0; ks < 4; ++ks) { const float* wp = WSm + ((size_t)(h * 128 + trow)) * 128 + 32 * ks + 8 * fq; wreg[ks][0] = *(const f32x4*)wp; wreg[ks][1] = *(const f32x4*)(wp + 4); }
                    const size_t row = (size_t)chunk * 128 + trow;
                    v2u uu[8];
#pragma unroll
                    for (int d = 0; d < 8; ++d) uu[d] = *(const v2u*)(UV + row * 4096 + h * 128 + 16 * d + 4 * fq);
                    const float bias = BSm[h * 128 + trow];
                    __syncthreads();
                    { float s1 = 0.f, s2 = 0.f;
#pragma unroll
                      for (int k = 0; k < 8; ++k) { s1 += pp[k].x; s2 += pp[k].y; }
#pragma unroll
                      for (int o = 1; o < 4; o <<= 1) { s1 += __builtin_bit_cast(float, __builtin_amdgcn_ds_bpermute((lane ^ o) << 2, __builtin_bit_cast(int, s1))); s2 += __builtin_bit_cast(float, __builtin_amdgcn_ds_bpermute((lane ^ o) << 2, __builtin_bit_cast(int, s2))); }
                      const float mean = s1 * (1.f / DM); if (part == 0) ST[sr] = (f32x2v){mean, 1.f / sqrtf(fmaxf(s2 * (1.f / DM) - mean * mean, 0.f) + LN_EPS)}; }
                    __syncthreads();
                    {
#pragma unroll
                      for (int i = 0; i < 4; ++i) { const int vrow = (tid >> 4) + 32 * i;
                        const v4u r = vraw[i]; const f32x2v st = ST[vrow]; const float mean = st.x, rstd = st.y;
                        v4u w; w.x = pk2((bflo(r.x) - mean) * rstd * g0[0] + b0[0], (bfhi(r.x) - mean) * rstd * g0[1] + b0[1]); w.y = pk2((bflo(r.y) - mean) * rstd * g0[2] + b0[2], (bfhi(r.y) - mean) * rstd * g0[3] + b0[3]);
                        w.z = pk2((bflo(r.z) - mean) * rstd * g1[0] + b1[0], (bfhi(r.z) - mean) * rstd * g1[1] + b1[1]); w.w = pk2((bflo(r.w) - mean) * rstd * g1[2] + b1[2], (bfhi(r.w) - mean) * rstd * g1[3] + b1[3]);
                        *(LAS v4u*)(lds + vrow * VS + ch * 16) = w; } }
                    __syncthreads();
                    f32x4 acc[8];
#pragma unroll
                    for (int d = 0; d < 8; ++d) acc[d] = (f32x4){0.f, 0.f, 0.f, 0.f};
#pragma unroll
                    for (int ks = 0; ks < 4; ++ks) if (ks < nks) {
                        const int s0 = 32 * ks + 8 * fq;
                        const f32x4 w0 = wreg[ks][0], w1 = wreg[ks][1];
                        float wv[8] = {w0[0], w0[1], w0[2], w0[3], w1[0], w1[1], w1[2], w1[3]};
#pragma unroll
                        for (int e = 0; e < 8; ++e) wv[e] = (s0 + e <= trow) ? wv[e] : 0.f;
                        v4u wpk; wpk.x = pk2(wv[0], wv[1]); wpk.y = pk2(wv[2], wv[3]); wpk.z = pk2(wv[4], wv[5]); wpk.w = pk2(wv[6], wv[7]);
                        const bf16x8 wfrag = __builtin_bit_cast(bf16x8, wpk);
                        LAS unsigned char* vb = lds + (32 * ks + 8 * fq + ((lane & 15) >> 2)) * VS + (4 * (lane & 3)) * 2;
#pragma unroll
                        for (int d = 0; d < 8; ++d) {
                            const s16x4 lo = __builtin_bit_cast(s16x4, __builtin_amdgcn_ds_read_tr16_b64_v4i16((LAS s16x4*)(vb + d * 32)));
                            const s16x4 hi4 = __builtin_bit_cast(s16x4, __builtin_amdgcn_ds_read_tr16_b64_v4i16((LAS s16x4*)(vb + d * 32 + 4 * VS)));
                            const bf16x8 vfrag = (bf16x8){lo[0], lo[1], lo[2], lo[3], hi4[0], hi4[1], hi4[2], hi4[3]};
                            acc[d] = __builtin_amdgcn_mfma_f32_16x16x32_bf16(vfrag, wfrag, acc[d], 0, 0, 0);
                        }
                    }
#pragma unroll
                    for (int d = 0; d < 8; ++d) { const int col = h * 128 + 16 * d + 4 * fq;
                        v2u o; o.x = pk2(bflo(uu[d].x) * (acc[d][0] + bias), bfhi(uu[d].x) * (acc[d][1] + bias)); o.y = pk2(bflo(uu[d].y) * (acc[d][2] + bias), bfhi(uu[d].y) * (acc[d][3] + bias));
                        *(v2u*)(T2 + row * LDK + col) = o; }
                }
                for (int idx = bx * 512 + tid; idx < DECB * 1024; idx += G * 512) {
                    const int sb = idx >> 10, c = (idx & 1023) * 2, h = c >> 7; const size_t r0 = (size_t)MP + sb * 8;
                    __syncthreads();
                    if (tid < 256) { const int r = tid >> 5, jj = tid & 31; const f32x2v p = *(const f32x2v*)(VST + ((r0 + r) * 32 + jj) * 2); float s1 = p.x, s2 = p.y;
#pragma unroll
                        for (int o = 1; o < 32; o <<= 1) { s1 += __builtin_bit_cast(float, __builtin_amdgcn_ds_bpermute((lane ^ o) << 2, __builtin_bit_cast(int, s1))); s2 += __builtin_bit_cast(float, __builtin_amdgcn_ds_bpermute((lane ^ o) << 2, __builtin_bit_cast(int, s2))); }
                        const float mean = s1 * (1.f / DM); if (jj == 0) ST[r] = (f32x2v){mean, 1.f / sqrtf(fmaxf(s2 * (1.f / DM) - mean * mean, 0.f) + LN_EPS)}; }
                    __syncthreads();
                    float v0[8], v1[8];
#pragma unroll
                    for (int s = 0; s < 8; ++s) { const unsigned r = *(const unsigned*)(UV + (r0 + s) * 4096 + 2048 + c); const f32x2v st = ST[s]; const float mean = st.x, rstd = st.y;
                        v0[s] = (bflo(r) - mean) * rstd * lg[c] + lb[c]; v1[s] = (bfhi(r) - mean) * rstd * lg[c + 1] + lb[c + 1];
                        float* o = OUT + OFF_CV + ((size_t)jm * MS + (r0 - MP) + s) * DM + c; o[0] = v0[s]; o[1] = v1[s]; }
#pragma unroll
                    for (int t = 0; t < 8; ++t) { float m0 = BSm[h * 128 + t], m1 = m0;
#pragma unroll
                        for (int s = 0; s < 8; ++s) if (s <= t) { const float w = WSm[(size_t)(h * 128 + t) * 128 + s]; m0 += w * v0[s]; m1 += w * v1[s]; }
                        const unsigned uu = *(const unsigned*)(UV + (r0 + t) * 4096 + c);
                        *(unsigned*)(T2 + (r0 + t) * LDK + c) = pk2(bflo(uu) * m0, bfhi(uu) * m1); }
                }
                }
            }
            PH_END();
            og_a = WS_T2; og_b = WS_AOUT + (size_t)jm * DM * LDK * 2;
        } else if (kind == 1) {
            if (PH_ON()) {
                PH_IDS(); PH_PTRS();
                const float* SP = INP(2) + (size_t)jm * DECB * 15 * DM;
                for (int rep = 0; rep < REP_POOL; ++rep) {
#define POOL_RAW(r, jj) (*(const v2u*)(XB + xb_idx((int)(r), 4 * (lane + 64 * (jj)))))
#define POOL_CV(w_) ((f32x4){bflo((w_).x), bfhi((w_).x), bflo((w_).y), bfhi((w_).y)})
#define POOL_LOAD(W, J, NH, rw) do { _Pragma("unroll") for (int h = 0; h < NH; ++h) _Pragma("unroll") for (int k = 0; k < W + 3; ++k) { const int rr = m0 - (W - 1) + k; rw[h][k] = POOL_RAW((rr < m0 - t0) ? m0 : rr, J + h); } } while (0)
#define POOL_OUT(W, J, NH, rw) do { _Pragma("unroll") for (int h = 0; h < NH; ++h) { f32x4 xf[W + 3]; _Pragma("unroll") for (int k = 0; k < W + 3; ++k) xf[k] = POOL_CV(rw[h][k]); \
                        _Pragma("unroll") for (int r = 0; r < 4; ++r) { const int t = t0 + r, cnt = (t + 1 < W) ? t + 1 : W; const f32x4 xc = xf[W - 1 + r]; f32x4 a = xc; \
                            _Pragma("unroll") for (int i = 1; i < W; ++i) a += (i < cnt) ? xf[W - 1 + r - i] : (f32x4){0.f, 0.f, 0.f, 0.f}; \
                            const f32x4 pv = a * (1.0f / (float)cnt) - xc; v2u o; o.x = pk2(pv[0], pv[1]); o.y = pk2(pv[2], pv[3]); *((v2u*)(T1 + (size_t)(m0 + r) * LDK) + lane + 64 * (J + h)) = o; \
                            if (t >= SEQ - 15) *((f32x4*)(OUT + OFF_PP + ((size_t)(jm * NBATCH + b) * 15 + (t - (SEQ - 15))) * DM) + lane + 64 * (J + h)) = xc; } } } while (0)
                for (int it = gw; it < MP / 4; it += NGW) {
                    const int m0 = 4 * it, t0 = m0 & (SEQ - 1), b = m0 >> 11;
                    v2u r2[2][5], r4[2][7]; POOL_LOAD(2, 0, 2, r2); POOL_LOAD(4, 2, 2, r4); POOL_OUT(2, 0, 2, r2);
                    v2u r8[2][11]; POOL_LOAD(8, 4, 2, r8); POOL_OUT(4, 2, 2, r4);
                    v2u ra[1][19]; POOL_LOAD(16, 6, 1, ra); POOL_OUT(8, 4, 2, r8);
                    v2u rb[1][19]; POOL_LOAD(16, 7, 1, rb); POOL_OUT(16, 6, 1, ra); POOL_OUT(16, 7, 1, rb);
                }
#undef POOL_LOAD
#undef POOL_OUT
                for (int it = gw; it < DECB * 8; it += NGW) {
                    const int sb = it >> 3, jj = it & 7, W = 2 << (jj >> 1); const size_t r0 = (size_t)MP + sb * 8;
                    f32x4 hs[15], xs[8];
#pragma unroll
                    for (int q = 0; q < 15; ++q) hs[q] = *((const f32x4*)(SP + ((size_t)sb * 15 + q) * DM) + lane + 64 * jj);
#pragma unroll
                    for (int t = 0; t < 8; ++t) { const v2u w_ = POOL_RAW(r0 + t, jj); xs[t] = POOL_CV(w_); }
                    float* ps = OUT + OFF_PS + ((size_t)(jm * DECB + sb) * 15) * DM;
#pragma unroll
                    for (int t = 0; t < 8; ++t) { const f32x4 xc = xs[t]; f32x4 a = xc;
#pragma unroll
                        for (int i = 1; i < 16; ++i) { const int q = 15 + t - i; const f32x4 xv = (q >= 15) ? xs[q >= 15 ? q - 15 : 0] : hs[q < 15 ? q : 0]; a += (i < W) ? xv : (f32x4){0.f, 0.f, 0.f, 0.f}; }
                        const f32x4 pv = a * (1.0f / (float)W) - xc; v2u o; o.x = pk2(pv[0], pv[1]); o.y = pk2(pv[2], pv[3]); *((v2u*)(T1 + (r0 + t) * LDK) + lane + 64 * jj) = o;
                        *((f32x4*)(ps + (size_t)(7 + t) * DM) + lane + 64 * jj) = xc;
                        if (t < 7) *((f32x4*)(ps + (size_t)t * DM) + lane + 64 * jj) = hs[8 + t]; }
                }
#undef POOL_RAW
#undef POOL_CV
                }
            }
            PH_END();
            og_a = WS_T1; og_b = WS_BGRP; og_ldb = 512; og_K = 512; og_gt = 2; og_gk = 512; ocs_on = 1;
        } else {
            if (PH_ON()) {
                PH_PTRS();
                pg8::Gemm g{XB, (const bf16*)(ws + WS_CIN), 32, 32, DM, 1 << 20, 0, (long)M * 128, (long)6144 * 128}; pg8::DpOrder S; S.init(MP / 256, 24, G, bx, false);
                pg8::EpiConvIn E{UV, OUT + OFF_CP + (size_t)jm * NBATCH * 2 * DM, OUT + OFF_CS + (size_t)jm * DECB * 2 * DM};
                for (int rep = 0; rep < REP_MG; ++rep)
                pg8::gemm_phase<pg8::EpiConvIn, pg8::DpOrder, true, true, 1, true>(lds + RING_OFF, g, S, E, opaque_tid(wave_id));
            }
            PH_END();
            if (PH_ON()) {
                PH_IDS(); PH_PTRS();
                const float* HC = INP(3) + (size_t)jm * DECB * 2 * DM; const float* WC = INP(23) + (size_t)jm * 3 * DM;
                for (int rep = 0; rep < REP_CG; ++rep)
                for (int m = gw; m < M; m += NGW) {
                    int t, sb = 0; if (m < MP) t = m & (SEQ - 1); else { const int lr = m - MP; sb = lr >> 3; t = lr & 7; }
#pragma unroll
                    for (int j = 0; j < 4; ++j) { const int c = 8 * (lane + 64 * j);
                        const v4u zb = *(const v4u*)(UV + (size_t)m * 4096 + 2048 + c), bb = *(const v4u*)(UV + (size_t)m * 4096 + c);
                        float z[8] = {bflo(zb.x), bfhi(zb.x), bflo(zb.y), bfhi(zb.y), bflo(zb.z), bfhi(zb.z), bflo(zb.w), bfhi(zb.w)};
                        float bg[8] = {bflo(bb.x), bfhi(bb.x), bflo(bb.y), bfhi(bb.y), bflo(bb.z), bfhi(bb.z), bflo(bb.w), bfhi(bb.w)};
                        float z1[8], z2[8];
                        if (t >= 1) { const v4u r = *(const v4u*)(UV + (size_t)(m - 1) * 4096 + 2048 + c);
                            z1[0] = bflo(r.x); z1[1] = bfhi(r.x); z1[2] = bflo(r.y); z1[3] = bfhi(r.y); z1[4] = bflo(r.z); z1[5] = bfhi(r.z); z1[6] = bflo(r.w); z1[7] = bfhi(r.w); }
                        else if (m >= MP) { const float* hp = HC + ((size_t)sb * 2 + 1) * DM + c;
#pragma unroll
                            for (int e = 0; e < 8; ++e) z1[e] = hp[e]; }
                        else {
#pragma unroll
                            for (int e = 0; e < 8; ++e) z1[e] = 0.f; }
                        if (t >= 2) { const v4u r = *(const v4u*)(UV + (size_t)(m - 2) * 4096 + 2048 + c);
                            z2[0] = bflo(r.x); z2[1] = bfhi(r.x); z2[2] = bflo(r.y); z2[3] = bfhi(r.y); z2[4] = bflo(r.z); z2[5] = bfhi(r.z); z2[6] = bflo(r.w); z2[7] = bfhi(r.w); }
                        else if (m >= MP) { const float* hp = HC + ((size_t)sb * 2 + t) * DM + c;
#pragma unroll
                            for (int e = 0; e < 8; ++e) z2[e] = hp[e]; }
                        else {
#pragma unroll
                            for (int e = 0; e < 8; ++e) z2[e] = 0.f; }
                        float o[8];
#pragma unroll
                        for (int e = 0; e < 8; ++e) o[e] = bg[e] * (WC[2 * DM + c + e] * z[e] + WC[DM + c + e] * z1[e] + WC[c + e] * z2[e]);
                        v4u w; w.x = pk2(o[0], o[1]); w.y = pk2(o[2], o[3]); w.z = pk2(o[4], o[5]); w.w = pk2(o[6], o[7]);
                        *(v4u*)(T1 + (size_t)m * LDK + c) = w; }
                }
            }
            PH_END();
            og_a = WS_T1; og_b = WS_COUT;
        }
        if (PH_ON()) {
            PH_PTRS();
            const pg8::Gemm og{(const bf16*)(ws + og_a), (const bf16*)(ws + og_b), og_lda, og_ldb, og_K, og_gt, og_gk, og_ksa, og_ksb};
#if FUSE_LN
            const int gi = (sub == 0) ? 8 : (sub == 1 ? 10 : 12);
            pg8::PanelOrder S{bx};
            pg8::EpiResidLN E{step == 11 ? X : nullptr, ocs_on ? INP(21) + (size_t)jm * DM : nullptr, os,
                              INP(gi) + (size_t)L * DM, INP(gi + 1) + (size_t)L * DM, XB, (unsigned long long*)(ws + WS_SLOT), ctl + CW_LN + step * LN_BANK, ctl + CW_TMO};
            if (sub != 1) pg8::gemm_phase<pg8::EpiResidLN, pg8::PanelOrder, true, true, 1, true>(lds + RING_OFF, og, S, E, opaque_tid(wave_id));
            else pg8::gemm_phase<pg8::EpiResidLN, pg8::PanelOrder, true, true, 1>(lds + RING_OFF, og, S, E, opaque_tid(wave_id));
#else
            pg8::DpOrder S; S.init(M / 256, 8, G, bx, SUB_ON);
            pg8::EpiResid E{step == 0 ? INP(0) : X, step == 0 ? INP(1) : X + (size_t)MP * DM, X, ocs_on ? INP(21) + (size_t)jm * DM : nullptr, os};
            for (int rep = 0; rep < (step == 0 ? REP_DOWN0 : 1); ++rep, (rep < (step == 0 ? REP_DOWN0 : 1) ? xcd_barrier(bar, opaque_tid(wave_id)) : (void)0))
            { pg8::gemm_phase<pg8::EpiResid, pg8::DpOrder, true, true>(lds + RING_OFF, og, S, E, opaque_tid(wave_id)); pg8::gemm_sub_phase<pg8::EpiResid, pg8::DpOrder>(lds + RING_OFF, og, S, E, opaque_tid(wave_id)); }
#endif
        }
        PH_END();
#if !FUSE_LN
        if (PH_ON()) {
            PH_IDS(); PH_PTRS();
            const int gi = (sub == 0) ? 8 : (sub == 1 ? 10 : 12);
            const float* lg = INP(gi) + (size_t)L * DM; const float* lb = INP(gi + 1) + (size_t)L * DM;
            for (int rep = 0; rep < REP_LN; ++rep)
            for (int m = gw; m < M; m += NGW) {
                const bool dummy = rep < REP_LN - 1;
                f32x4* xr = (f32x4*)(X + (size_t)m * DM) + lane; f32x4* xw = dummy ? (f32x4*)((float*)(ws + WS_PART) + (size_t)m * DM) + lane : xr;
                f32x4 v[8]; float s = 0.f;
#pragma unroll
                for (int j = 0; j < 8; ++j) { v[j] = xr[64 * j]; s += (v[j].x + v[j].y) + (v[j].z + v[j].w); }
                const float mean = wave_sum(s, lane) * (1.f / DM); float s2 = 0.f;
#pragma unroll
                for (int j = 0; j < 8; ++j) { v[j] = v[j] - mean; s2 += (v[j].x * v[j].x + v[j].y * v[j].y) + (v[j].z * v[j].z + v[j].w * v[j].w); }
                const float rstd = 1.f / sqrtf(wave_sum(s2, lane) * (1.f / DM) + LN_EPS);
                v2u* o8 = (v2u*)((dummy ? T2 : XB) + (size_t)m * LDK) + lane;
#pragma unroll
                for (int j = 0; j < 8; ++j) { const f32x4 gg = *((const f32x4*)lg + lane + 64 * j), bb = *((const f32x4*)lb + lane + 64 * j);
                    const f32x4 o = v[j] * rstd * gg + bb; xw[64 * j] = o; v2u w; w.x = pk2(o.x, o.y); w.y = pk2(o.z, o.w); o8[64 * j] = w; }
            }
        }
        PH_END();
#endif
    }
#undef PH_ON
#undef PH_END
#undef PH_IDS
#undef PH_PTRS
#undef INP
}

constexpr int N_PHASES = 1 + 8 * 3 + (4 + 3 + 4 + 4) - (FUSE_LN ? 12 : 0);

extern "C" void kernel_launch(void* const* d_in, const int* in_sizes, int n_in, void* d_out, int out_size, void* d_ws, size_t ws_size, hipStream_t stream) {
    static int grid = 0;
    if (grid == 0) {
        if (n_in != 25 || (size_t)out_size != OUT_TOTAL || ws_size < WS_END) { fprintf(stderr, "kernel_launch: unexpected shapes: n_in %d out %d ws %zu (need %zu)\n", n_in, out_size, ws_size, (size_t)WS_END); grid = -1; return; }
        int dev = 0, cus = 0, per_cu = 0;
        if (hipGetDevice(&dev) != hipSuccess || hipDeviceGetAttribute(&cus, hipDeviceAttributeMultiprocessorCount, dev) != hipSuccess) { grid = -1; return; }
        if (hipFuncSetAttribute((const void*)fwd_kernel, hipFuncAttributeMaxDynamicSharedMemorySize, LDS_BYTES) != hipSuccess) { fprintf(stderr, "kernel_launch: hipFuncSetAttribute failed\n"); grid = -1; return; }
        if (hipOccupancyMaxActiveBlocksPerMultiprocessor(&per_cu, (const void*)fwd_kernel, NWAVES * 64, LDS_BYTES) != hipSuccess || per_cu < 1)
            fprintf(stderr, "kernel_launch: note: occupancy query reports %d workgroups per CU\n", per_cu);
        (void)hipGetLastError();
        grid = cus;
    }
    if (grid < 0) return;
    if (hipMemsetAsync((char*)d_ws + WS_CTL, 0, CTL_ZERO_BYTES, stream) != hipSuccess) { fprintf(stderr, "kernel_launch: memset failed\n"); return; }
    Args a{};
    for (int i = 0; i < 25; ++i) a.in[i] = (const float*)d_in[i];
    a.out = (float*)d_out; a.ws = (unsigned char*)d_ws;
#if MK_PER_PHASE
    for (int p = 0; p < N_PHASES; ++p) { a.ph_lo = p; a.ph_hi = p + 1; hipLaunchKernelGGL(fwd_kernel, dim3(grid), dim3(NWAVES * 64), LDS_BYTES, stream, a); }
#else
    a.ph_lo = 0; a.ph_hi = N_PHASES;
    hipLaunchKernelGGL(fwd_kernel, dim3(grid), dim3(NWAVES * 64), LDS_BYTES, stream, a);
#endif
    const hipError_t le = hipPeekAtLastError();
    if (le != hipSuccess) fprintf(stderr, "kernel_launch: launch failed: %s\n", hipGetErrorName(le));
}
```

```cpp
#include <hip/hip_runtime.h>
#include <cstdio>
#include <cstdint>

#define PG8_BK32 1
#define PG8_ASYM 0
#define FUSE_LN 1
#define SUB_ON 1
#define REP_PRO 1
#define REP_UP 1
#define REP_DOWN0 1
#define REP_LN 1
#define REP_LNV 1
#define REP_BAR 1
#define REP_MG 1
#define REP_MIX 1
#define REP_POOL 1
#define REP_CG 1
#ifndef MK_PER_PHASE
#define MK_PER_PHASE 0
#endif

constexpr int DM = 2048, SEQ = 2048, NBATCH = 4, DECB = 128, DECS = 8, DFF = 5504;
constexpr int MP = NBATCH * SEQ, MS = DECB * DECS, M = MP + MS;
constexpr int LDK = DM + 64;
constexpr float ALPHA = 1.6817928305074290861f;
constexpr float LN_EPS = 1e-5f;
constexpr size_t OFF_Y = 0, OFF_PP = (size_t)M * DM, OFF_PS = OFF_PP + (size_t)NBATCH * 15 * DM, OFF_CP = OFF_PS + (size_t)DECB * 15 * DM,
                 OFF_CS = OFF_CP + (size_t)NBATCH * 2 * DM, OFF_CV = OFF_CS + (size_t)DECB * 2 * DM, OUT_TOTAL = OFF_CV + (size_t)2 * MS * DM;

namespace pg8 {
#define PG8_LAS __attribute__((address_space(3)))
typedef unsigned short bf16_t;
typedef short bf16x8 __attribute__((ext_vector_type(8)));
typedef float f32x4 __attribute__((ext_vector_type(4)));
typedef float f32x2 __attribute__((ext_vector_type(2)));
typedef unsigned u32x4 __attribute__((ext_vector_type(4)));
typedef unsigned u32x2 __attribute__((ext_vector_type(2)));
constexpr int BM = 256, BK = 64, HALF = 128, HTB = HALF * BK * 2  , STAGE_BYTES = 8 * HTB, NXCD = 8, WGM = 4;

__host__ __device__ __forceinline__ int lds_byte(int r, int c) { const int st = (r >> 4) * 2 + (c >> 5), rr = r & 15, cc = c & 31, ob = rr * 64 + cc * 2; return st * 1024 + (ob ^ (((ob >> 9) & 1) << 5)); }
__host__ __device__ __forceinline__ void stage_rc(int b, int& R, int& C) { const int st = b / 1024, sb = b % 1024, swz = sb ^ (((sb >> 9) & 1) << 5); R = (st >> 1) * 16 + swz / 64; C = (st & 1) * 32 + (swz % 64) / 2; }
__host__ __device__ __forceinline__ int perm32(int rho) { const int n = rho >> 4, i = rho & 15; return 8 * (i >> 2) + 4 * n + (i & 3); }

struct Unit { int pm, pn; };
struct Gemm { const bf16_t* A; const bf16_t* Bt; int lda, ldb, K, grp_tiles, grp_koff; long ksa, ksb; };

struct DpOrder {
    int nM, nN, nx, j, base, Tx, Rdp, rem;
    __device__ __forceinline__ void init(int nM_, int nN_, int G, int bx, bool sub) {
        asm volatile("" : "+s"(bx), "+s"(G));
        nM = nM_; nN = nN_; const int nwg = nM * nN, NX = (G % NXCD == 0) ? NXCD : 1; nx = G / NX; const int x = bx % NX; j = bx / NX;
        const int q = nwg / NX, r = nwg % NX; Tx = q + (x < r ? 1 : 0); base = x < r ? x * (q + 1) : r * (q + 1) + (x - r) * q;
        Rdp = Tx / nx; rem = Tx % nx; if (!sub && rem) { ++Rdp; rem = 0; }
        Tx = __builtin_amdgcn_readfirstlane(Tx); base = __builtin_amdgcn_readfirstlane(base); Rdp = __builtin_amdgcn_readfirstlane(Rdp); rem = __builtin_amdgcn_readfirstlane(rem); j = __builtin_amdgcn_readfirstlane(j); nx = __builtin_amdgcn_readfirstlane(nx);
    }
    __device__ __forceinline__ void tile(int wgid, Unit& u) const { const int nig = WGM * nN, gid = wgid / nig, fm = gid * WGM, gsz = (nM - fm) < WGM ? (nM - fm) : WGM;
        u.pm = __builtin_amdgcn_readfirstlane(fm + ((wgid % nig) % gsz)); u.pn = __builtin_amdgcn_readfirstlane((wgid % nig) / gsz); }
    __device__ __forceinline__ bool next(int i, Unit& u) const { if (i >= Rdp || nx * i + j >= Tx) return false; tile(base + nx * i + j, u); return true; }
    __device__ __forceinline__ bool next_sub(int i, Unit& u, int& sub) const { const int su = nx * i + j; if (su >= 8 * rem) return false; tile(base + Rdp * nx + (su >> 3), u); sub = su & 7; return true; }
    __device__ __forceinline__ bool hasx(const Unit&) const { return true; }
    __device__ __forceinline__ void a_ready(const Unit&) const {}
    __device__ __forceinline__ void done(const Unit&) const {}
};

__device__ __forceinline__ unsigned cvt_pk_bf16(float lo, float hi) { unsigned r; asm volatile("v_cvt_pk_bf16_f32 %0, %1, %2" : "=v"(r) : "v"(lo), "v"(hi)); return r; }
__device__ __forceinline__ f32x2 gelu_pk(f32x2 v) {
    const f32x2 av = __builtin_elementwise_abs(v), d = av * 0.2316418882f + 1.0f;
    f32x2 t; t.x = __builtin_amdgcn_rcpf(d.x); t.y = __builtin_amdgcn_rcpf(d.y);
    f32x2 q = t * 0.5307027145f + (-0.7265760135f); q = q * t + 0.7107068705f; q = q * t + (-0.142248368f); q = q * t + 0.127414796f; q = q * t;
    const f32x2 s = (v * v) * (-0.72134752044f);
    f32x2 e; e.x = __builtin_amdgcn_exp2f(s.x); e.y = __builtin_amdgcn_exp2f(s.y);
    const f32x2 m = v * (q * e), r = v - m;
    f32x2 o; o.x = v.x < 0.f ? m.x : r.x; o.y = v.y < 0.f ? m.y : r.y; return o;
}
__device__ __forceinline__ float silu_f(float g) { return g * __builtin_amdgcn_rcpf(1.0f + __builtin_amdgcn_exp2f(g * -1.4426950408889634f)); }
__device__ __forceinline__ u32x4 pack8(const f32x4& a, const f32x4& b) { u32x4 w; w.x = cvt_pk_bf16(a[0], a[1]); w.y = cvt_pk_bf16(a[2], a[3]); w.z = cvt_pk_bf16(b[0], b[1]); w.w = cvt_pk_bf16(b[2], b[3]); return w; }
__device__ __forceinline__ __amdgpu_buffer_rsrc_t wt_rsrc(const void* base) { return __builtin_amdgcn_make_buffer_rsrc((void*)base, 0, 0x7fffffff, 0x00020000); }
#define PG8_EPI_CALL() \
    __device__ __forceinline__ void operator()(const f32x4 (&acc)[2][2][4][2], const Unit& u, int wr, int wc, int fr, int fq) const { \
        _Pragma("unroll") for (int ai = 0; ai < 2; ++ai) _Pragma("unroll") for (int m = 0; m < 4; ++m) \
            grp(acc[ai][0][m][0], acc[ai][0][m][1], acc[ai][1][m][0], acc[ai][1][m][1], u, u.pm * BM + ai * HALF + wr * 64 + m * 16 + fr, wc, fq); }

template <int ACT> struct EpiBf16 {
    static constexpr bool PERM = true, AFTER_DRAIN = false, INIT_ACC = false;
    bf16_t* O; int ldc; float* vst;
    __device__ __forceinline__ void grp(f32x4 v00, f32x4 v01, f32x4 v10, f32x4 v11, const Unit& u, int row, int wc, int fq) const {
        bf16_t* rowp = O + (size_t)row * ldc + u.pn * BM + wc * 32 + 8 * fq;
        if (ACT == 1) { f32x2 a = gelu_pk((f32x2){v00[0], v00[1]}), b = gelu_pk((f32x2){v00[2], v00[3]}), c = gelu_pk((f32x2){v01[0], v01[1]}), d = gelu_pk((f32x2){v01[2], v01[3]});
            v00 = (f32x4){a.x, a.y, b.x, b.y}; v01 = (f32x4){c.x, c.y, d.x, d.y};
            a = gelu_pk((f32x2){v10[0], v10[1]}); b = gelu_pk((f32x2){v10[2], v10[3]}); c = gelu_pk((f32x2){v11[0], v11[1]}); d = gelu_pk((f32x2){v11[2], v11[3]});
            v10 = (f32x4){a.x, a.y, b.x, b.y}; v11 = (f32x4){c.x, c.y, d.x, d.y}; }
        *(u32x4*)rowp = pack8(v00, v01); *(u32x4*)(rowp + HALF) = pack8(v10, v11);
        if (vst && u.pn >= 8) { const int lane = (row & 15) + 16 * fq;
            float s1 = ((v00[0] + v00[1]) + (v00[2] + v00[3])) + ((v01[0] + v01[1]) + (v01[2] + v01[3])) + ((v10[0] + v10[1]) + (v10[2] + v10[3])) + ((v11[0] + v11[1]) + (v11[2] + v11[3]));
            float s2 = ((v00[0] * v00[0] + v00[1] * v00[1]) + (v00[2] * v00[2] + v00[3] * v00[3])) + ((v01[0] * v01[0] + v01[1] * v01[1]) + (v01[2] * v01[2] + v01[3] * v01[3]))
                     + ((v10[0] * v10[0] + v10[1] * v10[1]) + (v10[2] * v10[2] + v10[3] * v10[3])) + ((v11[0] * v11[0] + v11[1] * v11[1]) + (v11[2] * v11[2] + v11[3] * v11[3]));
#pragma unroll
            for (int o = 16; o < 64; o <<= 1) { s1 += __builtin_bit_cast(float, __builtin_amdgcn_ds_bpermute((lane ^ o) << 2, __builtin_bit_cast(int, s1))); s2 += __builtin_bit_cast(float, __builtin_amdgcn_ds_bpermute((lane ^ o) << 2, __builtin_bit_cast(int, s2))); }
            if (fq == 0) *(f32x2*)(vst + (((size_t)row * 8 + (u.pn - 8)) * 4 + wc) * 2) = (f32x2){s1, s2}; }
    }
    PG8_EPI_CALL()
};
struct EpiSwiGLU {
    static constexpr bool PERM = true, AFTER_DRAIN = false, INIT_ACC = false;
    bf16_t* O; int ldc;
    __device__ __forceinline__ void grp(f32x4 g0, f32x4 g1, f32x4 u0, f32x4 u1, const Unit& u, int row, int wc, int fq) const {
        f32x4 h0, h1;
#pragma unroll
        for (int e = 0; e < 4; ++e) { h0[e] = silu_f(g0[e]) * u0[e]; h1[e] = silu_f(g1[e]) * u1[e]; }
        const int col = u.pn * HALF + wc * 32 + 8 * fq;
        *(u32x4*)(O + ((size_t)(col >> 6) * M + row) * 64 + (col & 63)) = pack8(h0, h1);
    }
    PG8_EPI_CALL()
};
struct EpiConvIn {
    static constexpr bool PERM = true, AFTER_DRAIN = false, INIT_ACC = false;
    bf16_t* BZ; float* out_cp; float* out_cs;
    __device__ __forceinline__ void grp(f32x4 v00, f32x4 v01, f32x4 v10, f32x4 v11, const Unit& u, int row, int wc, int fq) const {
        if (u.pn < 8) { bf16_t* rowp = BZ + (size_t)row * 4096 + u.pn * BM + wc * 32 + 8 * fq; *(u32x4*)rowp = pack8(v00, v01); *(u32x4*)(rowp + HALF) = pack8(v10, v11); }
        else { const int col0 = (u.pn - 8) * HALF + wc * 32 + 8 * fq; const f32x4 z0 = v00 * v10, z1 = v01 * v11;
            *(u32x4*)(BZ + (size_t)row * 4096 + 2048 + col0) = pack8(z0, z1);
            if (row < MP) { const int t = row & (SEQ - 1);
                if (t >= SEQ - 2) { float* o = out_cp + ((size_t)(row >> 11) * 2 + (t - (SEQ - 2))) * DM + col0; *(f32x4*)o = z0; *(f32x4*)(o + 4) = z1; } }
            else { const int lr = row - MP, t = lr & 7;
                if (t >= 6) { float* o = out_cs + ((size_t)(lr >> 3) * 2 + (t - 6)) * DM + col0; *(f32x4*)o = z0; *(f32x4*)(o + 4) = z1; } } }
    }
    PG8_EPI_CALL()
};
struct EpiResid {
    static constexpr bool PERM = false, AFTER_DRAIN = false, INIT_ACC = false;
    const float* res_p; const float* res_s; float* out; const float* colscale; float s;
    __device__ __forceinline__ void grp(f32x4 v00, f32x4 v01, f32x4 v10, f32x4 v11, const Unit& u, int row, int wc, int fq) const {
        const int col0 = u.pn * BM + wc * 32 + 4 * fq;
        const float* rp = ((row < MP) ? res_p + (size_t)row * DM : res_s + (size_t)(row - MP) * DM) + col0; float* op = out + (size_t)row * DM + col0;
        f32x4 c00 = (f32x4){s, s, s, s}, c01 = c00, c10 = c00, c11 = c00;
        if (colscale) { c00 = *(const f32x4*)(colscale + col0) * s; c01 = *(const f32x4*)(colscale + col0 + 16) * s; c10 = *(const f32x4*)(colscale + col0 + HALF) * s; c11 = *(const f32x4*)(colscale + col0 + HALF + 16) * s; }
        const f32x4 r00 = *(const f32x4*)rp, r01 = *(const f32x4*)(rp + 16), r10 = *(const f32x4*)(rp + HALF), r11 = *(const f32x4*)(rp + HALF + 16);
        *(f32x4*)op = r00 * ALPHA + v00 * c00; *(f32x4*)(op + 16) = r01 * ALPHA + v01 * c01; *(f32x4*)(op + HALF) = r10 * ALPHA + v10 * c10; *(f32x4*)(op + HALF + 16) = r11 * ALPHA + v11 * c11;
    }
    PG8_EPI_CALL()
};

struct UpOrder {
    int bx, part;
    __device__ __forceinline__ void unit(int r, Unit& u) const { const int x = bx & 7, i = 32 * r + (bx >> 3);
        if (i < 172) { u.pm = 4 * x + (i & 3); u.pn = i >> 2; } else { u.pm = 32 + (x >> 1); u.pn = (x & 1) * 20 + (i - 172); } }
    __device__ __forceinline__ bool host() const { return (bx >> 3) < 12; }
    __device__ __forceinline__ bool next(int r, Unit& u) const {
        if (part == 0) { if (r >= 6 || (r == 5 && host())) return false; unit(r, u); return true; }
        if (r > 0 || !host()) return false; unit(5, u); return true; }
    __device__ __forceinline__ bool hasx(const Unit&) const { return true; }
    __device__ __forceinline__ void a_ready(const Unit&) const {}
    __device__ __forceinline__ void done(const Unit&) const {}
};
struct PanelOrder {
    int bx;
    __device__ __forceinline__ bool next(int i, Unit& u) const { if (i) return false; const int x = bx & 7, j = bx >> 3; u.pm = 4 * x + (j >> 3); u.pn = j & 7; return true; }
    __device__ __forceinline__ bool hasx(const Unit&) const { return true; }
    __device__ __forceinline__ void a_ready(const Unit&) const {}
    __device__ __forceinline__ void done(const Unit&) const {}
};
struct EpiResidLN {
    static constexpr bool PERM = true, AFTER_DRAIN = true, INIT_ACC = true;
    float* out; const float* colscale; float s;
    const float* lng; const float* lnb; bf16_t* xb; unsigned long long* slots; unsigned* cnt; unsigned* tmo;
    typedef __attribute__((address_space(1))) unsigned gu32_t; typedef __attribute__((address_space(1))) unsigned long long gu64_t;
    static __device__ __forceinline__ float lx(float v, int lane, int o) { return __builtin_bit_cast(float, __builtin_amdgcn_ds_bpermute((lane ^ o) << 2, __builtin_bit_cast(int, v))); }
    __device__ __forceinline__ void wait_cnt(unsigned* c, unsigned want, int lane, PG8_LAS unsigned* flag) const {
        unsigned sp = 0; bool dead = false;
        while ((unsigned)__builtin_amdgcn_readfirstlane(__hip_atomic_load((gu32_t*)c, __ATOMIC_RELAXED, __HIP_MEMORY_SCOPE_AGENT)) < want) {
            __builtin_amdgcn_s_sleep(1);
            if ((++sp & 255u) == 0u) { if (__builtin_amdgcn_readfirstlane(__hip_atomic_load((gu32_t*)tmo, __ATOMIC_RELAXED, __HIP_MEMORY_SCOPE_AGENT))) { dead = true; break; }
                if (sp > (1u << 18)) { if (lane == 0) __hip_atomic_fetch_add((gu32_t*)tmo, 1u, __ATOMIC_RELAXED, __HIP_MEMORY_SCOPE_AGENT); dead = true; break; } } }
        __builtin_amdgcn_fence(__ATOMIC_ACQUIRE, "agent");
        if (lane == 0) flag[0] = dead ? 1u : 0u;
    }
    __device__ __forceinline__ void ldres(u32x2 (&r)[4], int row, int col0) const { const __amdgpu_buffer_rsrc_t rs = wt_rsrc(xb); const unsigned o = (unsigned)(((col0 >> 5) * M + row) * 32 + (col0 & 31)) * 2u;
        const u32x4 a = __builtin_amdgcn_raw_buffer_load_b128(rs, o, 0, 0), b = __builtin_amdgcn_raw_buffer_load_b128(rs, o, 4u * M * 64u, 0);
        r[0] = (u32x2){a.x, a.y}; r[1] = (u32x2){a.z, a.w}; r[2] = (u32x2){b.x, b.y}; r[3] = (u32x2){b.z, b.w}; }
    static __device__ __forceinline__ f32x4 bf4(u32x2 w) { return (f32x4){__uint_as_float(w.x << 16), __uint_as_float(w.x & 0xffff0000u), __uint_as_float(w.y << 16), __uint_as_float(w.y & 0xffff0000u)}; }
    __device__ __forceinline__ void init_load(u32x2 (&rs)[9][4], const Unit& u, int wr, int wc, int fr, int fq) const { const int col0 = u.pn * BM + wc * 32 + 8 * fq;
#pragma unroll
        for (int ai = 0; ai < 2; ++ai)
#pragma unroll
            for (int m = 0; m < 4; ++m) ldres(rs[ai * 4 + m], u.pm * BM + ai * HALF + wr * 64 + m * 16 + fr, col0);
        ldres(rs[8], MP + 32 * u.pm + wr * 16 + fr, col0); }
    __device__ __forceinline__ void init_cvt(f32x4 (&acc)[2][2][4][2], f32x4 (&accx)[2][2], const u32x2 (&rs)[9][4]) const { const float k = ALPHA / s;
#pragma unroll
        for (int ai = 0; ai < 2; ++ai)
#pragma unroll
            for (int m = 0; m < 4; ++m) { acc[ai][0][m][0] = bf4(rs[ai * 4 + m][0]) * k; acc[ai][0][m][1] = bf4(rs[ai * 4 + m][1]) * k; acc[ai][1][m][0] = bf4(rs[ai * 4 + m][2]) * k; acc[ai][1][m][1] = bf4(rs[ai * 4 + m][3]) * k; }
        accx[0][0] = bf4(rs[8][0]) * k; accx[0][1] = bf4(rs[8][1]) * k; accx[1][0] = bf4(rs[8][2]) * k; accx[1][1] = bf4(rs[8][3]) * k; }
    __device__ __forceinline__ void yrow(f32x4& v00, f32x4& v01, f32x4& v10, f32x4& v11, int lane, float& mw, float& q) const {
        v00 = v00 * s; v01 = v01 * s; v10 = v10 * s; v11 = v11 * s;
        float t = ((v00[0] + v00[1]) + (v00[2] + v00[3])) + ((v01[0] + v01[1]) + (v01[2] + v01[3])) + ((v10[0] + v10[1]) + (v10[2] + v10[3])) + ((v11[0] + v11[1]) + (v11[2] + v11[3]));
        t += lx(t, lane, 16); t += lx(t, lane, 32); mw = t * (1.0f / 64.0f);
        const f32x4 d0 = v00 - mw, d1 = v01 - mw, d2 = v10 - mw, d3 = v11 - mw;
        float u = ((d0[0] * d0[0] + d0[1] * d0[1]) + (d0[2] * d0[2] + d0[3] * d0[3])) + ((d1[0] * d1[0] + d1[1] * d1[1]) + (d1[2] * d1[2] + d1[3] * d1[3]))
                + ((d2[0] * d2[0] + d2[1] * d2[1]) + (d2[2] * d2[2] + d2[3] * d2[3])) + ((d3[0] * d3[0] + d3[1] * d3[1]) + (d3[2] * d3[2] + d3[3] * d3[3]));
        u += lx(u, lane, 16); u += lx(u, lane, 32); q = u;
    }
    __device__ __forceinline__ void xrow(const f32x4& v00, const f32x4& v01, const f32x4& v10, const f32x4& v11, int row, int col0, f32x2 sr, const f32x4 (&gg)[4], const f32x4 (&bb)[4]) const {
        const __amdgpu_buffer_rsrc_t rb = wt_rsrc(xb), ro = wt_rsrc(out); const unsigned bo = (unsigned)(((col0 >> 5) * M + row) * 32 + (col0 & 31)) * 2u, oo = (unsigned)(row * DM + col0) * 4u;
        const f32x4 o00 = (v00 - sr.x) * sr.y * gg[0] + bb[0], o01 = (v01 - sr.x) * sr.y * gg[1] + bb[1], o10 = (v10 - sr.x) * sr.y * gg[2] + bb[2], o11 = (v11 - sr.x) * sr.y * gg[3] + bb[3];
        if (out) { __builtin_amdgcn_raw_buffer_store_b128(__builtin_bit_cast(u32x4, o00), ro, oo, 0, 2); __builtin_amdgcn_raw_buffer_store_b128(__builtin_bit_cast(u32x4, o01), ro, oo + 16, 0, 2);
                   __builtin_amdgcn_raw_buffer_store_b128(__builtin_bit_cast(u32x4, o10), ro, oo + HALF * 4, 0, 2); __builtin_amdgcn_raw_buffer_store_b128(__builtin_bit_cast(u32x4, o11), ro, oo + HALF * 4 + 16, 0, 2); }
        else { __builtin_amdgcn_raw_buffer_store_b128(pack8(o00, o01), rb, bo, 0, 0); __builtin_amdgcn_raw_buffer_store_b128(pack8(o10, o11), rb, bo, 4u * M * 64u, 0); }
    }
    __device__ __forceinline__ void exchange(int rows, int row0, int xrow0, int pn, unsigned* counter, unsigned want, PG8_LAS unsigned char* lds, int wid, int lane) const {
        typedef float f32x2v __attribute__((ext_vector_type(2)));
        PG8_LAS f32x2v* P = (PG8_LAS f32x2v*)lds; PG8_LAS f32x2v* S = (PG8_LAS f32x2v*)(lds + 9216); PG8_LAS unsigned* flag = (PG8_LAS unsigned*)(lds + 9216 + 2304);
        asm volatile("s_waitcnt lgkmcnt(0)" ::: "memory"); __builtin_amdgcn_s_barrier(); asm volatile("" ::: "memory");
        const int row = wid * 36 + lane; const bool mine = lane < 36 && row < rows; const size_t grow = (size_t)((row < 256) ? row0 + row : xrow0 + row - 256);
        if (mine) { const f32x2v a = P[row * 4 + 0], b = P[row * 4 + 1], c = P[row * 4 + 2], d = P[row * 4 + 3];
            const float mt = (a.x + b.x + c.x + d.x) * 0.25f; const float da = a.x - mt, db = b.x - mt, dc = c.x - mt, dd = d.x - mt;
            const float m2 = (a.y + b.y) + (c.y + d.y) + 64.0f * ((da * da + db * db) + (dc * dc + dd * dd));
            __hip_atomic_store((gu64_t*)(slots + grow * 8 + pn), ((unsigned long long)__float_as_uint(m2) << 32) | __float_as_uint(mt), __ATOMIC_RELAXED, __HIP_MEMORY_SCOPE_AGENT); }
        asm volatile("s_waitcnt vmcnt(0)" ::: "memory");
        if (lane == 0 && wid * 36 < rows) __hip_atomic_fetch_add((gu32_t*)counter, 1u, __ATOMIC_RELAXED, __HIP_MEMORY_SCOPE_AGENT);
        if (wid == 0) wait_cnt(counter, want, lane, flag);
        asm volatile("s_waitcnt vmcnt(0) lgkmcnt(0)" ::: "memory"); __builtin_amdgcn_s_barrier(); asm volatile("" ::: "memory");
        if (mine) { const unsigned long long* sl = slots + grow * 8; float mt[8], m2[8]; float ms = 0.f;
#pragma unroll
            for (int t = 0; t < 8; ++t) { const unsigned long long w = __hip_atomic_load((gu64_t*)(sl + t), __ATOMIC_RELAXED, __HIP_MEMORY_SCOPE_AGENT); mt[t] = __uint_as_float((unsigned)w); m2[t] = __uint_as_float((unsigned)(w >> 32)); ms += mt[t]; }
            const float mean = ms * 0.125f; float q = 0.f;
#pragma unroll
            for (int t = 0; t < 8; ++t) { const float dm = mt[t] - mean; q += m2[t] + 256.0f * dm * dm; }
            S[row] = (f32x2v){mean, (flag[0] != 0u) ? __builtin_nanf("") : 1.0f / sqrtf(q * (1.0f / DM) + LN_EPS)}; }
        asm volatile("s_waitcnt lgkmcnt(0)" ::: "memory"); __builtin_amdgcn_s_barrier(); asm volatile("" ::: "memory");
    }
    __device__ __forceinline__ void fused_tile(f32x4 (&acc)[2][2][4][2], f32x4 (&accx)[2][2], const Unit& u, int wr, int wc, int fr, int fq, PG8_LAS unsigned char* lds, int wid, int lane) const {
        typedef float f32x2v __attribute__((ext_vector_type(2)));
        PG8_LAS f32x2v* P = (PG8_LAS f32x2v*)lds; const PG8_LAS f32x2v* S = (const PG8_LAS f32x2v*)(lds + 9216);
        const int col0 = u.pn * BM + wc * 32 + 8 * fq, xr0 = MP + 32 * u.pm, xl = 256 + wr * 16 + fr;
#pragma unroll
        for (int ai = 0; ai < 2; ++ai)
#pragma unroll
            for (int m = 0; m < 4; ++m) { const int rl = ai * HALF + wr * 64 + m * 16 + fr; float mw, q;
                yrow(acc[ai][0][m][0], acc[ai][0][m][1], acc[ai][1][m][0], acc[ai][1][m][1], lane, mw, q);
                if (fq == 0) P[rl * 4 + wc] = (f32x2v){mw, q}; }
        { float mw, q; yrow(accx[0][0], accx[0][1], accx[1][0], accx[1][1], lane, mw, q); if (fq == 0) P[xl * 4 + wc] = (f32x2v){mw, q}; }
        f32x4 gg[4], bb[4];
        gg[0] = *(const f32x4*)(lng + col0); gg[1] = *(const f32x4*)(lng + col0 + 4); gg[2] = *(const f32x4*)(lng + col0 + HALF); gg[3] = *(const f32x4*)(lng + col0 + HALF + 4);
        bb[0] = *(const f32x4*)(lnb + col0); bb[1] = *(const f32x4*)(lnb + col0 + 4); bb[2] = *(const f32x4*)(lnb + col0 + HALF); bb[3] = *(const f32x4*)(lnb + col0 + HALF + 4);
        exchange(288, u.pm * BM, xr0, u.pn, cnt + 64 * u.pm, 64u, lds, wid, lane);
#pragma unroll
        for (int ai = 0; ai < 2; ++ai)
#pragma unroll
            for (int m = 0; m < 4; ++m) { const int rl = ai * HALF + wr * 64 + m * 16 + fr;
                xrow(acc[ai][0][m][0], acc[ai][0][m][1], acc[ai][1][m][0], acc[ai][1][m][1], u.pm * BM + rl, col0, S[rl], gg, bb); }
        xrow(accx[0][0], accx[0][1], accx[1][0], accx[1][1], xr0 + wr * 16 + fr, col0, S[xl], gg, bb);
    }
    __device__ __forceinline__ void operator()(const f32x4 (&)[2][2][4][2], const Unit&, int, int, int, int) const {}
    __device__ __forceinline__ void grp(f32x4, f32x4, f32x4, f32x4, const Unit&, int, int, int) const {}
};

template <class Epi, class Sched, bool ALIGN_EPI = false, bool SP2 = false, int XMODE = 0  >
__device__ __forceinline__ void gemm_phase(PG8_LAS unsigned char* lds, const Gemm g, const Sched& S, const Epi& E, const int tid) {
    constexpr bool XROWS = XMODE != 0;
    static_assert(!XROWS || SP2, "XROWS is written for the two-super-phase loop");
    const int wid = __builtin_amdgcn_readfirstlane(tid >> 6), lane = tid & 63, wr = wid >> 2, wc = wid & 3, fr = lane & 15, fq = lane >> 4;
    const int K = g.K, nt = K / BK;
    unsigned voffA[2], voffB[2];
#pragma unroll
    for (int i = 0; i < 2; ++i) { int R, C; stage_rc(tid * 16 + i * 8192, R, C); const int Rb = Epi::PERM ? ((R & ~31) + perm32(R & 31)) : R;
        voffA[i] = (unsigned)(R * g.lda + C) * 2u; voffB[i] = (unsigned)(Rb * g.ldb + C) * 2u; }
    const __amdgpu_buffer_rsrc_t rsA = __builtin_amdgcn_make_buffer_rsrc((void*)g.A, 0, 0x7fffffff, 0x00020000), rsB = __builtin_amdgcn_make_buffer_rsrc((void*)g.Bt, 0, 0x7fffffff, 0x00020000);
    const unsigned ksa = (unsigned)g.ksa, ksb = (unsigned)g.ksb;
    const __amdgpu_buffer_rsrc_t rsA0 = __builtin_amdgcn_make_buffer_rsrc((void*)g.A, 0, 0, 0x00020000), rsB0 = __builtin_amdgcn_make_buffer_rsrc((void*)g.Bt, 0, 0, 0x00020000);
    const unsigned hstepA = (unsigned)HALF * g.lda * 2, hstepB = (unsigned)HALF * g.ldb * 2;
    const unsigned tstepA = 2 * hstepA, tstepB = 2 * hstepB;
    const unsigned ldsw = (unsigned)wid * 1024u;
    const int aoff = lds_byte(wr * 64 + fr, fq * 8), boff = lds_byte(wc * 32 + fr, fq * 8);
    const unsigned xadj = 0u;
    const int xoff = lds_byte(wr * 16 + fr, fq * 8);
    int xo = STAGE_BYTES + xoff, xst = STAGE_BYTES + 8192;
    constexpr bool BK32 = SP2 && (XMODE == 0) && (PG8_BK32 != 0);
    unsigned voffA1, voffB1, wAo, wBo; const unsigned ldsw2 = (unsigned)wid * 2048u;
    const unsigned khA = (g.lda == 32) ? ksa / 2u : 64u, khB = (g.ldb == 32) ? ksb / 2u : 64u;
    const unsigned xwo = (unsigned)((((wid & 3) >> 1) * 16) * g.lda) * 2u + (unsigned)(wid & 1) * khA + ((wid >= 4) ? ksa : 0u);
    { const int sb = lane * 16, swz = sb ^ (((sb >> 9) & 1) << 5), r = swz >> 6, cb = swz & 63;
      voffA1 = (unsigned)(r * g.lda) * 2u + (unsigned)cb; voffB1 = (unsigned)((Epi::PERM ? (8 * (r >> 2) + (r & 3)) : r) * g.ldb) * 2u + (unsigned)cb;
      wAo = (unsigned)(wid * 16 * g.lda) * 2u; wBo = (unsigned)((Epi::PERM ? (32 * (wid >> 1) + 4 * (wid & 1)) : wid * 16) * g.ldb) * 2u; }
#define Q_ST1(rs, bufoff, soff, voff) __builtin_amdgcn_raw_ptr_buffer_load_lds(rs, (PG8_LAS unsigned*)(lds + (bufoff) + ldsw2), 16, voff, soff, 0, 0)
#define Q_STAGE(b, kh, ta, tb, RSA, RSB) do { Q_ST1(RSA, PG8_SA(b, 0) + (kh) * 1024, (ta) + wAo + (kh) * khA, voffA1); Q_ST1(RSA, PG8_SA(b, 1) + (kh) * 1024, (ta) + hstepA + wAo + (kh) * khA, voffA1); \
        Q_ST1(RSB, PG8_SB(b, 0) + (kh) * 1024, (tb) + wBo + (kh) * khB, voffB1); Q_ST1(RSB, PG8_SB(b, 1) + (kh) * 1024, (tb) + hstepB + wBo + (kh) * khB, voffB1); } while (0)
#define Q_LD(b, kh) do { _Pragma("unroll") for (int ai = 0; ai < 2; ++ai) _Pragma("unroll") for (int m = 0; m < 4; ++m) At[m][ai] = *(const PG8_LAS bf16x8*)(lds + PG8_SA(b, ai) + aoff + m * 2048 + (kh) * 1024); \
        _Pragma("unroll") for (int bj = 0; bj < 2; ++bj) _Pragma("unroll") for (int n = 0; n < 2; ++n) B0[bj][n] = *(const PG8_LAS bf16x8*)(lds + PG8_SB(b, bj) + boff + n * 2048 + (kh) * 1024); } while (0)
#define Q_MMA() do { __builtin_amdgcn_s_setprio(1); _Pragma("unroll") for (int ai = 0; ai < 2; ++ai) _Pragma("unroll") for (int bj = 0; bj < 2; ++bj) _Pragma("unroll") for (int m = 0; m < 4; ++m) _Pragma("unroll") for (int n = 0; n < 2; ++n) \
        acc[ai][bj][m][n] = __builtin_amdgcn_mfma_f32_16x16x32_bf16(B0[bj][n], At[m][ai], acc[ai][bj][m][n], 0, 0, 0); __builtin_amdgcn_s_setprio(0); } while (0)
#define PG8_XS(b) (STAGE_BYTES + (b) * 8192)
#define PG8_XSTAGE(b, soff) do { if constexpr (XROWS) __builtin_amdgcn_raw_ptr_buffer_load_lds(rsA, (PG8_LAS unsigned*)(lds + PG8_XS(b) + ldsw), 16, voffA1, (soff) + xwo, 0, 0); } while (0)
#define PG8_XSTAGEQ(soff) do { if constexpr (XROWS) __builtin_amdgcn_raw_ptr_buffer_load_lds(rsA2, (PG8_LAS unsigned*)(lds + xst + ldsw), 16, voffA1, (soff) + xwo, 0, 0); } while (0)
#define PG8_LDX(b) do { if constexpr (XROWS) if (XMODE == 1 || hx) { _Pragma("unroll") for (int k = 0; k < 2; ++k) Xf[k] = *(const PG8_LAS bf16x8*)(lds + xo + (b) * 4096 + k * 1024); } } while (0)
#define PG8_MMAX() do { if constexpr (XROWS) { if (XMODE == 1 || hx) { __builtin_amdgcn_s_setprio(1); _Pragma("unroll") for (int k = 0; k < 2; ++k) _Pragma("unroll") for (int n = 0; n < 2; ++n) { \
        accx[0][n] = __builtin_amdgcn_mfma_f32_16x16x32_bf16(B0[n][k], Xf[k], accx[0][n], 0, 0, 0); accx[1][n] = __builtin_amdgcn_mfma_f32_16x16x32_bf16(B1[n][k], Xf[k], accx[1][n], 0, 0, 0); } \
        __builtin_amdgcn_s_setprio(0); } __builtin_amdgcn_sched_barrier(0); } } while (0)
#define PG8_XOFF(u) ((unsigned)(MP + 32 * (u).pm) * (unsigned)(g.lda * 2) + (unsigned)((u).pn / g.grp_tiles) * (unsigned)(g.grp_koff * 2))
#define PG8_SA(b, h) (((b) * 2 + (h)) * HTB)
#define PG8_SB(b, h) ((4 + (b) * 2 + (h)) * HTB)
#define PG8_STAGEX(rs, bufoff, soff, isb) do { Q_ST1(rs, (bufoff), (soff) + ((isb) ? wBo : wAo), ((isb) ? voffB1 : voffA1)); Q_ST1(rs, (bufoff) + 1024, (soff) + ((isb) ? wBo : wAo) + ((isb) ? khB : khA), ((isb) ? voffB1 : voffA1)); } while (0)
#define PG8_STAGE(bufoff, soff, voff, isb) PG8_STAGEX(((isb) ? rsB : rsA), bufoff, soff, isb)
#define PG8_STAGE2(bufoff, soff, voff, isb) PG8_STAGEX(((isb) ? rsB2 : rsA2), bufoff, soff, isb)
#define PG8_LDA(dst, b, h) do { _Pragma("unroll") for (int m = 0; m < 4; ++m) _Pragma("unroll") for (int k = 0; k < 2; ++k) dst[m][k] = *(const PG8_LAS bf16x8*)(lds + PG8_SA(b, h) + aoff + m * 2048 + k * 1024); } while (0)
#define PG8_LDB(dst, b, h) do { _Pragma("unroll") for (int n = 0; n < 2; ++n) _Pragma("unroll") for (int k = 0; k < 2; ++k) dst[n][k] = *(const PG8_LAS bf16x8*)(lds + PG8_SB(b, h) + boff + n * 2048 + k * 1024); } while (0)
#define PG8_MMA(ai, bj, At, Bt) do { __builtin_amdgcn_s_setprio(1); _Pragma("unroll") for (int m = 0; m < 4; ++m) _Pragma("unroll") for (int n = 0; n < 2; ++n) _Pragma("unroll") for (int k = 0; k < 2; ++k) \
        acc[ai][bj][m][n] = __builtin_amdgcn_mfma_f32_16x16x32_bf16(Bt[n][k], At[m][k], acc[ai][bj][m][n], 0, 0, 0); __builtin_amdgcn_s_setprio(0); } while (0)
#define PG8_WAIT_V(n) asm volatile("s_waitcnt vmcnt(" #n ")" ::: "memory")
#define PG8_WAIT_L(n) asm volatile("s_waitcnt lgkmcnt(" #n ")" ::: "memory")
#define PG8_BAR __builtin_amdgcn_s_barrier()
#define PG8_SCHED __builtin_amdgcn_sched_barrier(0)
#define PG8_AOFF(u) ((unsigned)(u).pm * tstepA + (unsigned)((u).pn / g.grp_tiles) * (unsigned)(g.grp_koff * 2))
    Unit cur, nxt; int ui = 0;
    if (!S.next(0, cur)) return;
    f32x4 acc[2][2][4][2];
    bf16x8 At[4][2], B0[2][2], B1[2][2]; bf16x8 Xf[2]; f32x4 accx[2][2];
    if constexpr (!Epi::INIT_ACC) {
#pragma unroll
    for (int a = 0; a < 2; ++a)
#pragma unroll
        for (int b = 0; b < 2; ++b)
#pragma unroll
            for (int m = 0; m < 4; ++m)
#pragma unroll
                for (int n = 0; n < 2; ++n) acc[a][b][m][n] = (f32x4){0.f, 0.f, 0.f, 0.f};
#pragma unroll
    for (int b = 0; b < 2; ++b)
#pragma unroll
        for (int n = 0; n < 2; ++n) accx[b][n] = (f32x4){0.f, 0.f, 0.f, 0.f};
    }
    bool hx = false; if constexpr (XMODE == 2) hx = S.hasx(cur);
    unsigned cA = PG8_AOFF(cur), cB = (unsigned)cur.pn * tstepB, cX = (XMODE == 1 || hx) ? PG8_XOFF(cur) : cA + xadj;
    S.a_ready(cur);
    u32x2 irs[9][4];
    if constexpr (Epi::INIT_ACC) E.init_load(irs, cur, wr, wc, fr, fq);
    if constexpr (BK32) {
        Q_STAGE(0, 0, cA, cB, rsA, rsB); Q_STAGE(0, 1, cA, cB, rsA, rsB); Q_STAGE(1, 0, cA + ksa, cB + ksb, rsA, rsB);
        if (wr == 1) PG8_BAR;
        PG8_WAIT_V(8);
        PG8_BAR; PG8_BAR;
    } else if constexpr (SP2) {
        PG8_STAGE(PG8_SB(0, 0), cB, voffB, 1); PG8_STAGE(PG8_SB(0, 1), cB + hstepB, voffB, 1); PG8_STAGE(PG8_SA(0, 0), cA, voffA, 0); PG8_STAGE(PG8_SA(0, 1), cA + hstepA, voffA, 0); PG8_XSTAGE(0, cX);
        if (wr == 1) PG8_BAR;
        if constexpr (XROWS) PG8_WAIT_V(3); else PG8_WAIT_V(2);
        PG8_BAR;
        PG8_STAGE(PG8_SB(1, 0), cB + ksb, voffB, 1); PG8_STAGE(PG8_SA(1, 0), cA + ksa, voffA, 0); PG8_STAGE(PG8_SB(1, 1), cB + hstepB + ksb, voffB, 1);
        PG8_WAIT_V(6); PG8_BAR;
        if (PG8_ASYM && wr == 1) { PG8_STAGE(PG8_SA(1, 1), cA + hstepA + ksa, voffA, 0); PG8_XSTAGE(1, cX + ksa); }
    } else {
        PG8_STAGE(PG8_SB(0, 0), cB, voffB, 1); PG8_STAGE(PG8_SA(0, 0), cA, voffA, 0); PG8_STAGE(PG8_SB(0, 1), cB + hstepB, voffB, 1); PG8_STAGE(PG8_SA(0, 1), cA + hstepA, voffA, 0);
        if (wr == 1) PG8_BAR;
        PG8_WAIT_V(4); PG8_BAR;
        PG8_STAGE(PG8_SB(1, 0), cB + ksb, voffB, 1); PG8_STAGE(PG8_SA(1, 0), cA + ksa, voffA, 0); PG8_STAGE(PG8_SB(1, 1), cB + hstepB + ksb, voffB, 1);
        PG8_WAIT_V(6); PG8_BAR;
    }
    if constexpr (Epi::INIT_ACC) E.init_cvt(acc, accx, irs);
    for (;;) {
        const bool has_next = S.next(ui + 1, nxt);
        asm volatile("" : "+s"(cA), "+s"(cB), "+s"(cX));
        unsigned nA = has_next ? PG8_AOFF(nxt) : cA, nB = has_next ? (unsigned)nxt.pn * tstepB : cB; bool nhx = false; if constexpr (XMODE == 2) nhx = has_next && S.hasx(nxt);
        unsigned nX = has_next ? ((XMODE == 1 || nhx) ? PG8_XOFF(nxt) : nA + xadj) : cX; asm volatile("" : "+s"(nA), "+s"(nB), "+s"(nX));
        for (int t = 0; t < nt; t += 2) {
            const bool last = (t == nt - 2);
            const unsigned a1 = cA + (unsigned)(t + 1) * ksa;
            const unsigned a2 = last ? nA : cA + (unsigned)(t + 2) * ksa, b2 = last ? nB : cB + (unsigned)(t + 2) * ksb;
            const unsigned a3 = a2 + ksa, b3 = b2 + ksb;
            if (last && has_next) S.a_ready(nxt);
            const bool dry = last && !has_next;
            const __amdgpu_buffer_rsrc_t rsA2 = dry ? rsA0 : rsA, rsB2 = dry ? rsB0 : rsB;
            if constexpr (BK32) {
            const unsigned b1t = cB + (unsigned)(t + 1) * ksb;
            Q_LD(0, 0); PG8_SCHED; Q_STAGE(1, 1, a1, b1t, rsA, rsB);  PG8_WAIT_V(8); PG8_WAIT_L(0); PG8_BAR; Q_MMA(); PG8_SCHED; PG8_BAR; PG8_SCHED;
            Q_LD(0, 1); PG8_SCHED; Q_STAGE(0, 0, a2, b2, rsA2, rsB2); PG8_WAIT_V(8); PG8_WAIT_L(0); PG8_BAR; Q_MMA(); PG8_SCHED; PG8_BAR; PG8_SCHED;
            Q_LD(1, 0); PG8_SCHED; Q_STAGE(0, 1, a2, b2, rsA2, rsB2); PG8_WAIT_V(8); PG8_WAIT_L(0); PG8_BAR; Q_MMA(); PG8_SCHED; PG8_BAR; PG8_SCHED;
            Q_LD(1, 1); PG8_SCHED; Q_STAGE(1, 0, a3, b3, rsA2, rsB2); PG8_WAIT_V(8); PG8_WAIT_L(0); PG8_BAR; Q_MMA(); PG8_SCHED; PG8_BAR; PG8_SCHED;
            } else if constexpr (SP2) {
#define PG8_WAIT_SPA() PG8_WAIT_V(8)
#define PG8_WAIT_SPB() do { if constexpr (XROWS) PG8_WAIT_V(9); else PG8_WAIT_V(8); } while (0)
            const unsigned x1 = cX + (unsigned)(t + 1) * ksa, x2 = last ? nX : cX + (unsigned)(t + 2) * ksa, x3 = x2 + ksa;
            const bool WL = PG8_ASYM && (wr == 0), IE = PG8_ASYM && (wr == 1);
            PG8_LDB(B0, 0, 0); PG8_LDB(B1, 0, 1); PG8_SCHED; PG8_LDA(At, 0, 0); if (!IE) { PG8_STAGE(PG8_SA(1, 1), a1 + hstepA, voffA, 0); }
            if (!WL) PG8_WAIT_SPA(); PG8_WAIT_L(0); PG8_BAR;
            if (IE) { PG8_STAGE2(PG8_SB(0, 0), b2, voffB, 1); PG8_STAGE2(PG8_SB(0, 1), b2 + hstepB, voffB, 1); PG8_STAGE2(PG8_SA(0, 0), a2, voffA, 0); }
            PG8_MMA(0, 0, At, B0); PG8_MMA(0, 1, At, B1); PG8_SCHED; if (WL) PG8_WAIT_SPA(); PG8_BAR; PG8_SCHED;
            PG8_LDA(At, 0, 1); PG8_LDX(0); if (!IE) { PG8_STAGE2(PG8_SB(0, 0), b2, voffB, 1); PG8_STAGE2(PG8_SB(0, 1), b2 + hstepB, voffB, 1); PG8_STAGE2(PG8_SA(0, 0), a2, voffA, 0); }
            if (!WL) PG8_WAIT_SPA(); PG8_WAIT_L(0); PG8_BAR;
            if (IE) { PG8_STAGE2(PG8_SA(0, 1), a2 + hstepA, voffA, 0); PG8_XSTAGE(0, x2); }
            PG8_MMA(1, 0, At, B0); PG8_MMA(1, 1, At, B1); PG8_MMAX(); PG8_SCHED; if (WL) PG8_WAIT_SPA(); PG8_BAR; PG8_SCHED;
            PG8_LDB(B0, 1, 0); PG8_LDB(B1, 1, 1); PG8_SCHED; PG8_LDA(At, 1, 0); if (!IE) { PG8_STAGE2(PG8_SA(0, 1), a2 + hstepA, voffA, 0); PG8_XSTAGEQ(x2); }
            if (!WL) PG8_WAIT_SPB(); PG8_WAIT_L(0); PG8_BAR;
            if (IE) { PG8_STAGE2(PG8_SB(1, 0), b3, voffB, 1); PG8_STAGE2(PG8_SB(1, 1), b3 + hstepB, voffB, 1); PG8_STAGE2(PG8_SA(1, 0), a3, voffA, 0); }
            PG8_MMA(0, 0, At, B0); PG8_MMA(0, 1, At, B1); PG8_SCHED; if (WL) PG8_WAIT_SPB(); PG8_BAR; PG8_SCHED;
            PG8_LDA(At, 1, 1); PG8_LDX(1); if (!IE) { PG8_STAGE2(PG8_SB(1, 0), b3, voffB, 1); PG8_STAGE2(PG8_SB(1, 1), b3 + hstepB, voffB, 1); PG8_STAGE2(PG8_SA(1, 0), a3, voffA, 0); }
            if (!WL) PG8_WAIT_SPB(); PG8_WAIT_L(0); PG8_BAR;
            if (IE) { PG8_STAGE2(PG8_SA(1, 1), a3 + hstepA, voffA, 0); PG8_XSTAGE(1, x3); }
            PG8_MMA(1, 0, At, B0); PG8_MMA(1, 1, At, B1); PG8_MMAX(); PG8_SCHED; if (WL) PG8_WAIT_SPB(); PG8_BAR; PG8_SCHED;
            xo ^= 8192; xst ^= 8192;
#undef PG8_WAIT_SPA
#undef PG8_WAIT_SPB
            } else {
            PG8_LDB(B0, 0, 0); PG8_SCHED; PG8_LDA(At, 0, 0); PG8_STAGE(PG8_SA(1, 1), a1 + hstepA, voffA, 0);
            PG8_WAIT_L(8); PG8_BAR; PG8_WAIT_L(0); PG8_MMA(0, 0, At, B0); PG8_BAR; PG8_SCHED;
            PG8_LDB(B1, 0, 1); PG8_STAGE(PG8_SB(0, 0), b2, voffB, 1);
            PG8_BAR; PG8_WAIT_L(0); PG8_MMA(0, 1, At, B1); PG8_BAR;
            PG8_LDA(At, 0, 1); PG8_STAGE(PG8_SA(0, 0), a2, voffA, 0);
            PG8_BAR; PG8_WAIT_L(0); PG8_MMA(1, 0, At, B0); PG8_BAR; PG8_SCHED;
            PG8_STAGE(PG8_SB(0, 1), b2 + hstepB, voffB, 1);
            PG8_WAIT_V(6); PG8_BAR; PG8_MMA(1, 1, At, B1); PG8_BAR;
            PG8_LDB(B0, 1, 0); PG8_SCHED; PG8_LDA(At, 1, 0); PG8_STAGE(PG8_SA(0, 1), a2 + hstepA, voffA, 0);
            PG8_WAIT_L(8); PG8_BAR; PG8_WAIT_L(0); PG8_MMA(0, 0, At, B0); PG8_BAR; PG8_SCHED;
            PG8_LDB(B1, 1, 1); PG8_STAGE(PG8_SB(1, 0), b3, voffB, 1);
            PG8_BAR; PG8_WAIT_L(0); PG8_MMA(0, 1, At, B1); PG8_BAR;
            PG8_LDA(At, 1, 1); PG8_STAGE(PG8_SA(1, 0), a3, voffA, 0);
            PG8_BAR; PG8_WAIT_L(0); PG8_MMA(1, 0, At, B0); PG8_BAR; PG8_SCHED;
            PG8_STAGE(PG8_SB(1, 1), b3 + hstepB, voffB, 1);
            PG8_WAIT_V(6); PG8_BAR; PG8_MMA(1, 1, At, B1); PG8_BAR;
            }
        }
        if constexpr (ALIGN_EPI) { if (wr == 0) PG8_BAR; }
        if constexpr (!Epi::AFTER_DRAIN) { int el = lane; asm volatile("" : "+v"(el)); const int efr = el & 15, efq = el >> 4;
            E(acc, cur, wr, wc, efr, efq);
            if constexpr (XROWS) if (XMODE == 1 || hx) E.grp(accx[0][0], accx[0][1], accx[1][0], accx[1][1], cur, MP + 32 * cur.pm + wr * 16 + efr, wc, efq); }
        if (!has_next) break;
#pragma unroll
        for (int a = 0; a < 2; ++a)
#pragma unroll
            for (int b = 0; b < 2; ++b)
#pragma unroll
                for (int m = 0; m < 4; ++m)
#pragma unroll
                    for (int n = 0; n < 2; ++n) acc[a][b][m][n] = (f32x4){0.f, 0.f, 0.f, 0.f};
        if constexpr (XROWS) {
#pragma unroll
            for (int b = 0; b < 2; ++b)
#pragma unroll
                for (int n = 0; n < 2; ++n) accx[b][n] = (f32x4){0.f, 0.f, 0.f, 0.f}; }
        cur = nxt; cA = nA; cB = nB; cX = nX; hx = nhx; ++ui;
        if constexpr (ALIGN_EPI) { if (wr == 1) PG8_BAR; }
    }
    PG8_WAIT_V(0);
    if constexpr (!ALIGN_EPI) { if (wr == 0) PG8_BAR; }
    PG8_BAR;
    if constexpr (Epi::AFTER_DRAIN) E.fused_tile(acc, accx, cur, wr, wc, fr, fq, lds, wid, lane);
#undef PG8_SA
#undef PG8_SB
#undef PG8_LDA
#undef PG8_LDB
#undef PG8_MMA
#undef PG8_XS
#undef PG8_XSTAGE
#undef PG8_LDX
#undef PG8_MMAX
#undef PG8_XOFF
}

template <class Epi, class Sched>
__device__ __forceinline__ void gemm_sub_phase(PG8_LAS unsigned char* lds, const Gemm g, const Sched& S, const Epi& E, const int tid) {
    const int wid = __builtin_amdgcn_readfirstlane(tid >> 6), lane = tid & 63, wm = wid >> 2, wc = wid & 3, fr = lane & 15, fq = lane >> 4;
    const int nt = g.K / BK;
    unsigned voffA, voffB[2];
    { int R, C; stage_rc((tid & 255) * 16, R, C); voffA = (unsigned)(R * g.lda + C) * 2u; }
#pragma unroll
    for (int i = 0; i < 2; ++i) { int R, C; stage_rc(tid * 16 + i * 8192, R, C); const int Rb = Epi::PERM ? ((R & ~31) + perm32(R & 31)) : R; voffB[i] = (unsigned)(Rb * g.ldb + C) * 2u; }
    const size_t ksa = (size_t)g.ksa, ksb = (size_t)g.ksb, hstepB = (size_t)HALF * g.ldb * 2;
    const unsigned ldsw = (unsigned)wid * 1024u;
    const int aoff = lds_byte(wm * 16 + fr, fq * 8), boff = 4096 + lds_byte(wc * 32 + fr, fq * 8);
    constexpr int SS = 36864;
    const bool lda_wave = wid < 4;
#define PG8_SUBSTAGE(so, kt) do { const char* _a = gA + (size_t)(kt) * ksa; const char* _b = gB + (size_t)(kt) * ksb; \
        if (lda_wave) __builtin_amdgcn_global_load_lds((const unsigned*)(_a + voffA), (PG8_LAS unsigned*)(lds + (so) + ldsw), 16, 0, 0); \
        _Pragma("unroll") for (int _h = 0; _h < 2; ++_h) _Pragma("unroll") for (int _i = 0; _i < 2; ++_i) \
            __builtin_amdgcn_global_load_lds((const unsigned*)(_b + _h * hstepB + voffB[_i]), (PG8_LAS unsigned*)(lds + (so) + 4096 + _h * 16384 + _i * 8192 + ldsw), 16, 0, 0); } while (0)
    Unit u; int sub;
    for (int i = 0; S.next_sub(i, u, sub); ++i) {
        const char* gA = (const char*)g.A + ((size_t)u.pm * BM + sub * 32) * g.lda * 2 + (size_t)(u.pn / g.grp_tiles) * (size_t)g.grp_koff * 2;
        const char* gB = (const char*)g.Bt + (size_t)u.pn * BM * g.ldb * 2;
        f32x4 acc[2][2];
#pragma unroll
        for (int b = 0; b < 2; ++b)
#pragma unroll
            for (int n = 0; n < 2; ++n) acc[b][n] = (f32x4){0.f, 0.f, 0.f, 0.f};
        int s0 = 0, s1 = SS, s2 = 2 * SS, s3 = 3 * SS;
        PG8_SUBSTAGE(s0, 0); PG8_SUBSTAGE(s1, 1); PG8_SUBSTAGE(s2, (nt > 2 ? 2 : nt - 1));
        for (int t = 0; t < nt; ++t) {
            if (lda_wave) PG8_WAIT_V(10); else PG8_WAIT_V(8);
            PG8_BAR;
            const int tn = (t + 3 < nt) ? t + 3 : nt - 1;
            PG8_SUBSTAGE(s3, tn);
            bf16x8 Af[2], Bf[2][2][2];
#pragma unroll
            for (int k = 0; k < 2; ++k) Af[k] = *(const PG8_LAS bf16x8*)(lds + s0 + aoff + k * 1024);
#pragma unroll
            for (int b = 0; b < 2; ++b)
#pragma unroll
                for (int n = 0; n < 2; ++n)
#pragma unroll
                    for (int k = 0; k < 2; ++k) Bf[b][n][k] = *(const PG8_LAS bf16x8*)(lds + s0 + boff + b * 16384 + n * 2048 + k * 1024);
#pragma unroll
            for (int k = 0; k < 2; ++k)
#pragma unroll
                for (int b = 0; b < 2; ++b)
#pragma unroll
                    for (int n = 0; n < 2; ++n) acc[b][n] = __builtin_amdgcn_mfma_f32_16x16x32_bf16(Bf[b][n][k], Af[k], acc[b][n], 0, 0, 0);
            const int st = s0; s0 = s1; s1 = s2; s2 = s3; s3 = st;
        }
        PG8_WAIT_V(0); PG8_BAR;
        E.grp(acc[0][0], acc[0][1], acc[1][0], acc[1][1], u, u.pm * BM + sub * 32 + wm * 16 + fr, wc, fq);
    }
#undef PG8_SUBSTAGE
#undef PG8_AOFF
#undef PG8_STAGE
#undef PG8_WAIT_V
#undef PG8_WAIT_L
#undef PG8_BAR
#undef PG8_SCHED
}
}

constexpr size_t MiB = 1u << 20;
constexpr size_t WS_CTL = 0, CTL_ZERO_BYTES = 1 * MiB;
constexpr size_t SZ_WGU = (size_t)2 * DFF * LDK * 2, SZ_WD = (size_t)DM * DFF * 2;
constexpr size_t WS_WGU = 2 * MiB, WS_WD = WS_WGU + 8 * SZ_WGU;
constexpr size_t WS_AIN = WS_WD + 8 * SZ_WD, WS_AOUT = WS_AIN + 2 * (size_t)4096 * LDK * 2, WS_BGRP = WS_AOUT + 2 * (size_t)DM * LDK * 2,
                 WS_CIN = WS_BGRP + (size_t)DM * 512 * 2, WS_COUT = WS_CIN + (size_t)6144 * LDK * 2, WS_WEND = WS_COUT + (size_t)DM * LDK * 2;
constexpr size_t WS_XB = (WS_WEND + MiB - 1) / MiB * MiB;
constexpr size_t WS_ACT = WS_XB + (size_t)M * LDK * 2;
constexpr size_t WS_UV = WS_ACT + (size_t)M * DFF * 2;
constexpr size_t WS_T1 = WS_UV + (size_t)M * 4096 * 2;
constexpr size_t WS_T2 = WS_T1 + (size_t)M * LDK * 2;
constexpr size_t WS_PART = WS_T2 + (size_t)M * LDK * 2;
constexpr size_t WS_SLOT = WS_PART + (size_t)M * DM * 4;
constexpr size_t WS_VST = WS_SLOT + (size_t)M * 8 * 8;
constexpr size_t WS_END = WS_VST + (size_t)2 * M * 32 * 2 * 4;
constexpr int CW_BAR = 4096, CW_TMO = 0, CW_LN = 16384, LN_BANK = 128 * 64, CW_FLAG = 65536;

constexpr int RING_OFF = 0, RING_BYTES = 147456;
constexpr int LDSCTL_OFF = RING_BYTES, MISC_OFF = LDSCTL_OFF + 320;
constexpr int LDS_BYTES = 151552;
constexpr int NWAVES = 8;

#define GAS __attribute__((address_space(1)))
#define LAS __attribute__((address_space(3)))
typedef unsigned short bf16;
typedef unsigned v4u __attribute__((ext_vector_type(4)));
typedef unsigned v2u __attribute__((ext_vector_type(2)));
typedef float f32x4 __attribute__((ext_vector_type(4)));
typedef short bf16x8 __attribute__((ext_vector_type(8)));
typedef short s16x4 __attribute__((ext_vector_type(4)));
typedef float f32x2v __attribute__((ext_vector_type(2)));
#define LDS_WAIT() asm volatile("s_waitcnt lgkmcnt(0)" ::: "memory")
#define VM_WAIT() asm volatile("s_waitcnt vmcnt(0)" ::: "memory")
__device__ __forceinline__ int opaque_tid(int wave_id) { int l; asm volatile("v_mbcnt_lo_u32_b32 %0, -1, 0\n\tv_mbcnt_hi_u32_b32 %0, -1, %0" : "=v"(l)); return wave_id * 64 + l; }
__device__ __forceinline__ unsigned pk2(float lo, float hi) { return pg8::cvt_pk_bf16(lo, hi); }
__device__ __forceinline__ float bflo(unsigned u) { return __builtin_bit_cast(float, u << 16); }
__device__ __forceinline__ float bfhi(unsigned u) { return __builtin_bit_cast(float, u & 0xffff0000u); }

#define XB_TMO      128
#define XB_XCNT(j)  (256  + 64 * (j))
#define XB_XSUB(j)  (1280 + 64 * (j))
#define XB_XGEN(j)  (2304 + 64 * (j))
#define XB_TOP      3328
#define XB_TOPGEN   3392
#define XCD_BAR_WORDS 3456
#define XB_SPIN_CAP (1u << 18)
__device__ __forceinline__ unsigned xb_ld(unsigned* p)              { return __hip_atomic_load((GAS unsigned*)p, __ATOMIC_RELAXED, __HIP_MEMORY_SCOPE_AGENT); }
__device__ __forceinline__ unsigned xb_add(unsigned* p, unsigned v) { return __hip_atomic_fetch_add((GAS unsigned*)p, v, __ATOMIC_RELAXED, __HIP_MEMORY_SCOPE_AGENT); }
__device__ __forceinline__ unsigned xb_xcc_id() { return (unsigned)__builtin_amdgcn_s_getreg((3 << 11) | 20) & 0xFu; }
#define XB_SPIN(cond, bar) do { unsigned _sp = 0; while (cond) { __builtin_amdgcn_s_sleep(1); \
    if ((++_sp & 255u) == 0u) { if (xb_ld(&(bar)[XB_TMO])) break; if (_sp > XB_SPIN_CAP) { xb_add(&(bar)[XB_TMO], 1u); break; } } } } while (0)
struct XcdBarrier { unsigned* bar; unsigned x; volatile LAS unsigned* st; };
__device__ __forceinline__ XcdBarrier xcd_barrier_post(unsigned* bar, volatile LAS unsigned* st, int tid) {
    XcdBarrier b; b.bar = bar; b.x = xb_xcc_id(); b.st = st;
    if (tid == 0) (void)xb_add(&bar[XB_XCNT(b.x)], 1u);
    return b;
}
__device__ __forceinline__ void xcd_barrier_complete(unsigned* bar, unsigned x, unsigned& nloc, unsigned& nx) {
    const unsigned G = gridDim.x * gridDim.y * gridDim.z;
    unsigned sum, cnt, mine, sp = 0u;
    for (;;) {
        sum = 0u; cnt = 0u; mine = 0u;
#pragma unroll
        for (unsigned j = 0; j < 16; ++j) { const unsigned c = xb_ld(&bar[XB_XCNT(j)]); sum += c; cnt += (c > 0u) ? 1u : 0u; mine = (j == x) ? c : mine; }
        if (sum == G) break;
        __builtin_amdgcn_s_sleep(1);
        if ((++sp & 255u) == 0u) { if (xb_ld(&bar[XB_TMO])) break; if (sp > XB_SPIN_CAP) { xb_add(&bar[XB_TMO], 1u); break; } }
    }
    nloc = mine > 0u ? mine : 1u; nx = cnt > 0u ? cnt : 1u;
}
__device__ __forceinline__ void xcd_barrier(const XcdBarrier& b, int tid) {
    asm volatile("s_waitcnt vmcnt(0)" ::: "memory");
    __syncthreads();
    if (tid == 0) {
        unsigned* bar = b.bar; asm volatile("" : "+s"(bar)); bar = (unsigned*)(GAS unsigned*)bar;
        __builtin_amdgcn_s_waitcnt(0);
        unsigned nloc = b.st[0], nx = b.st[1];
        if (nloc == 0u) { xcd_barrier_complete(bar, b.x, nloc, nx); b.st[0] = nloc; b.st[1] = nx; }
        const unsigned old = xb_add(&bar[XB_XSUB(b.x)], 1u);
        const unsigned gen = old / nloc;
        if (old + 1u == (gen + 1u) * nloc) {
            __builtin_amdgcn_fence(__ATOMIC_RELEASE, "agent");
            asm volatile("s_waitcnt vmcnt(0)" ::: "memory");
            const unsigned og = xb_add(&bar[XB_TOP], 1u);
            const unsigned tg = og / nx;
            if (og + 1u == (tg + 1u) * nx) xb_add(&bar[XB_TOPGEN], 1u);
            else XB_SPIN(xb_ld(&bar[XB_TOPGEN]) == tg, bar);
            __builtin_amdgcn_fence(__ATOMIC_ACQUIRE, "agent");
            xb_add(&bar[XB_XGEN(b.x)], 1u);
            asm volatile("s_waitcnt vmcnt(0)" ::: "memory");
        } else {
            XB_SPIN(xb_ld(&bar[XB_XGEN(b.x)]) == gen, bar);
            __builtin_amdgcn_fence(__ATOMIC_ACQUIRE, "agent");
            asm volatile("s_waitcnt vmcnt(0)" ::: "memory");
        }
    }
    __syncthreads();
}

__device__ __forceinline__ float wave_sum(float v, int lane) {
#pragma unroll
    for (int o = 1; o < 64; o <<= 1) v += __builtin_bit_cast(float, __builtin_amdgcn_ds_bpermute((lane ^ o) << 2, __builtin_bit_cast(int, v)));
    return v;
}
__device__ __forceinline__ void p0_transpose_item(const float* W, int N, bf16* WT, int ldk, int k0, int n0, int drow0, LAS float* scr, int lane, int km_rows = 0  , int k32 = 0  , const float* colsc = nullptr  ) {
#pragma unroll 8
    for (int i = 0; i < 32; ++i) { const int kk = 2 * i + (lane >> 5); scr[kk * 33 + (lane & 31)] = __builtin_nontemporal_load(W + (size_t)(k0 + kk) * N + n0 + (lane & 31)); }
    LDS_WAIT(); asm volatile("" ::: "memory");
    const int c = lane & 7;
#pragma unroll
    for (int j = 0; j < 4; ++j) { const int n = (lane >> 3) + 8 * j; const LAS float* s = scr + (8 * c) * 33 + n;
        const float sc = colsc ? colsc[drow0 + n] : 1.0f;
        v4u o; o.x = pk2(s[0 * 33] * sc, s[1 * 33] * sc); o.y = pk2(s[2 * 33] * sc, s[3 * 33] * sc); o.z = pk2(s[4 * 33] * sc, s[5 * 33] * sc); o.w = pk2(s[6 * 33] * sc, s[7 * 33] * sc);
        if (k32) __builtin_nontemporal_store(o, (v4u*)(WT + ((size_t)((k0 >> 5) + (c >> 2)) * km_rows + drow0 + n) * 32 + 8 * (c & 3)));
        else if (km_rows) __builtin_nontemporal_store(o, (v4u*)(WT + ((size_t)(k0 >> 6) * km_rows + drow0 + n) * 64 + 8 * c)); else __builtin_nontemporal_store(o, (v4u*)(WT + (size_t)(drow0 + n) * ldk + k0 + 8 * c)); }
    LDS_WAIT(); asm volatile("" ::: "memory");
}

__device__ __forceinline__ size_t xb_idx(int m, int c) { return ((size_t)(c >> 5) * M + (size_t)m) * 32 + (size_t)(c & 31); }

struct Args { const float* in[25]; float* out; unsigned char* ws; int ph_lo, ph_hi; };

__global__ void __launch_bounds__(NWAVES * 64, 2) fwd_kernel(Args args) {
    extern __shared__ __attribute__((aligned(16))) unsigned char lds_raw[];
    LAS unsigned char* lds = (LAS unsigned char*)lds_raw;
    volatile LAS unsigned* MISC = (volatile LAS unsigned*)(lds + MISC_OFF);
    const int G = gridDim.x; const int bx = blockIdx.x;
    const int wave_id = __builtin_amdgcn_readfirstlane((int)threadIdx.x >> 6);
    const int vcu = (G % 8 == 0) ? (bx % 8) * (G / 8) + bx / 8 : bx;
    const int NGW = G * NWAVES;
#define PH_IDS() const int tid = opaque_tid(wave_id), lane = tid & 63, wave = __builtin_amdgcn_readfirstlane(tid >> 6), gw = vcu * NWAVES + wave; (void)lane; (void)gw
#define INP(i) ((const float*)(const GAS float*)ap->in[i])
#define PH_PTRS() const __attribute__((address_space(4))) Args* ap = (const __attribute__((address_space(4))) Args*)__builtin_amdgcn_kernarg_segment_ptr(); asm volatile("" : "+s"(ap)); \
    unsigned char* const ws = (unsigned char*)(GAS unsigned char*)ap->ws; unsigned* const ctl = (unsigned*)(ws + WS_CTL); float* const OUT = (float*)(GAS float*)ap->out; float* const X = OUT + OFF_Y; \
    bf16* const XB = (bf16*)(ws + WS_XB); bf16* const ACT = (bf16*)(ws + WS_ACT); bf16* const UV = (bf16*)(ws + WS_UV); bf16* const T1 = (bf16*)(ws + WS_T1); bf16* const T2 = (bf16*)(ws + WS_T2); \
    (void)ctl; (void)X; (void)XB; (void)ACT; (void)UV; (void)T1; (void)T2
    for (int u = threadIdx.x; u < (LDS_BYTES - LDSCTL_OFF) / 4; u += NWAVES * 64) ((LAS unsigned*)(lds + LDSCTL_OFF))[u] = 0u;
    __syncthreads();
    XcdBarrier bar; bar.bar = (unsigned*)(args.ws + WS_CTL) + CW_BAR; bar.x = 0; bar.st = nullptr;
    if (!MK_PER_PHASE) bar = xcd_barrier_post((unsigned*)(args.ws + WS_CTL) + CW_BAR, MISC + 8, (int)threadIdx.x);

    const int lo = args.ph_lo, hi = args.ph_hi;
    int ph = 0;
#define PH_ON() (lo <= ph && ph < hi)
#define PH_END() do { if (!MK_PER_PHASE && (ph + 1) < hi) for (int _r = 0; _r < REP_BAR; ++_r) xcd_barrier(bar, opaque_tid(wave_id)); ++ph; } while (0)

    if (PH_ON()) {
        PH_IDS(); PH_PTRS();
        LAS float* scr = (LAS float*)(lds + RING_OFF + wave * 16384);
        constexpr int I_GU = 32 * 344, I_D = 86 * 64, I_AIN = 32 * 128, I_SQ = 32 * 64, I_BG = 8 * 16, I_CIN = 32 * 192;
        constexpr int E0 = 4 * I_GU, E1 = E0 + 4 * I_D, E2 = E1 + 4 * I_GU, E3 = E2 + 4 * I_D, E4 = E3 + 2 * I_AIN, E5 = E4 + 2 * I_SQ, E6 = E5 + 4 * I_BG, E7 = E6 + I_CIN, E8 = E7 + I_SQ;
        for (int rep = 0; rep < REP_PRO; ++rep)
        for (int it = gw; it < E8; it += NGW) {
            if (it < E3) {
                const int which = (it >= E1) ? 1 : 0; int r = it - (which ? E1 : 0);
                if (r < E0) { const int mat = r / I_GU, q = r % I_GU, kb = q / 344, nb = q % 344, n0 = nb * 32;
                    const int nn = (n0 < DFF) ? n0 : n0 - DFF, drow0 = 256 * (nn >> 7) + (nn & 127) + ((n0 < DFF) ? 0 : 128);
                    p0_transpose_item(INP(which ? 6 : 4) + (size_t)mat * DM * 2 * DFF, 2 * DFF, (bf16*)(ws + WS_WGU + (size_t)(2 * mat + which) * SZ_WGU), LDK, kb * 64, n0, drow0, scr, lane, 2 * DFF, 1); }
                else { r -= E0; const int mat = r / I_D, q = r % I_D, kb = q / 64, nb = q % 64;
                    p0_transpose_item(INP(which ? 7 : 5) + (size_t)mat * DFF * DM, DM, (bf16*)(ws + WS_WD + (size_t)(2 * mat + which) * SZ_WD), DFF, kb * 64, nb * 32, nb * 32, scr, lane, DM); }
            } else if (it < E4) { const int r = it - E3, mat = r / I_AIN, q = r % I_AIN, kb = q / 128, nb = q % 128;
                p0_transpose_item(INP(14) + (size_t)mat * DM * 4096, 4096, (bf16*)(ws + WS_AIN) + (size_t)mat * 4096 * LDK, LDK, kb * 64, nb * 32, nb * 32, scr, lane);
            } else if (it < E5) { const int r = it - E4, mat = r / I_SQ, q = r % I_SQ, kb = q / 64, nb = q % 64;
                p0_transpose_item(INP(19) + (size_t)mat * DM * DM, DM, (bf16*)(ws + WS_AOUT) + (size_t)mat * DM * LDK, LDK, kb * 64, nb * 32, nb * 32, scr, lane);
            } else if (it < E6) { const int r = it - E5, mat = r / I_BG, q = r % I_BG, kb = q / 16, nb = q % 16;
                p0_transpose_item(INP(20) + (size_t)mat * 512 * 512, 512, (bf16*)(ws + WS_BGRP), 512, kb * 64, nb * 32, mat * 512 + nb * 32, scr, lane, 0, 0, INP(21));
            } else if (it < E7) { const int r = it - E6, kb = r / 192, nb = r % 192, n0 = nb * 32;
                int drow0; if (n0 < 2048) drow0 = n0; else { const int nn = (n0 < 4096) ? n0 - 2048 : n0 - 4096; drow0 = 2048 + 256 * (nn >> 7) + (nn & 127) + ((n0 < 4096) ? 0 : 128); }
                p0_transpose_item(INP(22), 6144, (bf16*)(ws + WS_CIN), LDK, kb * 64, n0, drow0, scr, lane);
            } else { const int r = it - E7, kb = r / 64, nb = r % 64;
                p0_transpose_item(INP(24), DM, (bf16*)(ws + WS_COUT), LDK, kb * 64, nb * 32, nb * 32, scr, lane); }
        }
        for (int m = gw; m < M; m += NGW) {
            const float* src = (m < MP) ? INP(0) + (size_t)m * DM : INP(1) + (size_t)(m - MP) * DM;
            const f32x4* xr = (const f32x4*)src + lane;
#pragma unroll
            for (int j = 0; j < 8; ++j) { const f32x4 v = __builtin_nontemporal_load(xr + 64 * j); v2u w; w.x = pk2(v.x, v.y); w.y = pk2(v.z, v.w); *(v2u*)(XB + xb_idx(m, 4 * (lane + 64 * j))) = w; }
        }
    }
    PH_END();

    for (int step = 0; step < 12; ++step) {
        const int L = step / 3, sub = step % 3, kind = L % 3, jm = L / 3;
        size_t og_a, og_b; int og_lda = LDK, og_ldb = LDK, og_K = DM, og_gt = 1 << 20, og_gk = 0, ocs_on = 0; long og_ksa = 128, og_ksb = 128; float os = 1.f;
        if (sub != 1) {
            const int hs = 2 * L + (sub == 2 ? 1 : 0);
            if (PH_ON()) {
                PH_PTRS();
                pg8::Gemm g{XB, (const bf16*)(ws + WS_WGU + (size_t)hs * SZ_WGU), 32, 32, DM, 1 << 20, 0, (long)M * 128, (long)2 * DFF * 128}; pg8::UpOrder S0{bx, 0}, S1{bx, 1};
                pg8::EpiSwiGLU E{ACT, DFF};
                for (int rep = 0; rep < REP_UP; ++rep, (rep < REP_UP ? xcd_barrier(bar, opaque_tid(wave_id)) : (void)0))
                { pg8::gemm_phase<pg8::EpiSwiGLU, pg8::UpOrder, true, true, 0>(lds + RING_OFF, g, S0, E, opaque_tid(wave_id)); pg8::gemm_phase<pg8::EpiSwiGLU, pg8::UpOrder, true, true, 1>(lds + RING_OFF, g, S1, E, opaque_tid(wave_id)); }
            }
            PH_END();
            og_a = WS_ACT; og_b = WS_WD + (size_t)hs * SZ_WD; og_lda = 64; og_ldb = 64; og_K = DFF; os = 0.5f; og_ksa = (long)M * 128; og_ksb = (long)DM * 128;
        } else if (kind == 0) {
            if (PH_ON()) {
                PH_PTRS();
                pg8::Gemm g{XB, (const bf16*)(ws + WS_AIN) + (size_t)jm * 4096 * LDK, 32, LDK, DM, 1 << 20, 0, (long)M * 128, 128}; pg8::DpOrder S; S.init(MP / 256, 16, G, bx, false);
                pg8::EpiBf16<1> E{UV, 4096, (float*)(ws + WS_VST) + (size_t)jm * M * 64};
                for (int rep = 0; rep < REP_MG; ++rep)
                pg8::gemm_phase<pg8::EpiBf16<1>, pg8::DpOrder, true, true, 1>(lds + RING_OFF, g, S, E, opaque_tid(wave_id));
            }
            PH_END();
            if (PH_ON()) {
                PH_IDS(); PH_PTRS();
                const float* WSm = INP(17) + (size_t)jm * 16 * 128 * 128; const float* BSm = INP(18) + (size_t)jm * 16 * 128;
                const float* lg = INP(15) + (size_t)jm * DM; const float* lb = INP(16) + (size_t)jm * DM; const float* VST = (const float*)(ws + WS_VST) + (size_t)jm * M * 64;
                LAS f32x2v* ST = (LAS f32x2v*)(lds + 40960);
                constexpr int VS = 272;
                const int fr = lane & 15, fq = lane >> 4;
                for (int rep = 0; rep < REP_MIX; ++rep) {
                for (int item = bx; item < 64 * 16; item += G) {
                    const int chunk = item >> 4, h = item & 15;
                    const int sr = tid >> 2, part = tid & 3; const f32x2v* ps = (const f32x2v*)(VST + (((size_t)chunk * 128 + sr) * 32 + part * 8) * 2);
                    f32x2v pp[8];
#pragma unroll
                    for (int k = 0; k < 8; ++k) pp[k] = ps[k];
                    const int ch = tid & 15, cb = h * 128 + ch * 8;
                    v4u vraw[4];
#pragma unroll
                    for (int i = 0; i < 4; ++i) vraw[i] = *(const v4u*)(UV + ((size_t)chunk * 128 + (tid >> 4) + 32 * i) * 4096 + 2048 + cb);
                    const f32x4 g0 = *(const f32x4*)(lg + cb), g1 = *(const f32x4*)(lg + cb + 4), b0 = *(const f32x4*)(lb + cb), b1 = *(const f32x4*)(lb + cb + 4);
                    const int t0 = 16 * wave, nks = (wave >> 1) + 1, trow = t0 + fr;
                    f32x4 wreg[4][2];
#pragma unroll
                    for (int ks = 0; ks < 4; ++ks) { const float* wp = WSm + ((size_t)(h * 128 + trow)) * 128 + 32 * ks + 8 * fq; wreg[ks][0] = *(const f32x4*)wp; wreg[ks][1] = *(const f32x4*)(wp + 4); }
                    const size_t row = (size_t)chunk * 128 + trow;
                    v2u uu[8];
#pragma unroll
                    for (int d = 0; d < 8; ++d) uu[d] = *(const v2u*)(UV + row * 4096 + h * 128 + 16 * d + 4 * fq);
                    const float bias = BSm[h * 128 + trow];
                    __syncthreads();
                    { float s1 = 0.f, s2 = 0.f;
#pragma unroll
                      for (int k = 0; k < 8; ++k) { s1 += pp[k].x; s2 += pp[k].y; }
#pragma unroll
                      for (int o = 1; o < 4; o <<= 1) { s1 += __builtin_bit_cast(float, __builtin_amdgcn_ds_bpermute((lane ^ o) << 2, __builtin_bit_cast(int, s1))); s2 += __builtin_bit_cast(float, __builtin_amdgcn_ds_bpermute((lane ^ o) << 2, __builtin_bit_cast(int, s2))); }
                      const float mean = s1 * (1.f / DM); if (part == 0) ST[sr] = (f32x2v){mean, 1.f / sqrtf(fmaxf(s2 * (1.f / DM) - mean * mean, 0.f) + LN_EPS)}; }
                    __syncthreads();
                    {
#pragma unroll
                      for (int i = 0; i < 4; ++i) { const int vrow = (tid >> 4) + 32 * i;
                        const v4u r = vraw[i]; const f32x2v st = ST[vrow]; const float mean = st.x, rstd = st.y;
                        v4u w; w.x = pk2((bflo(r.x) - mean) * rstd * g0[0] + b0[0], (bfhi(r.x) - mean) * rstd * g0[1] + b0[1]); w.y = pk2((bflo(r.y) - mean) * rstd * g0[2] + b0[2], (bfhi(r.y) - mean) * rstd * g0[3] + b0[3]);
                        w.z = pk2((bflo(r.z) - mean) * rstd * g1[0] + b1[0], (bfhi(r.z) - mean) * rstd * g1[1] + b1[1]); w.w = pk2((bflo(r.w) - mean) * rstd * g1[2] + b1[2], (bfhi(r.w) - mean) * rstd * g1[3] + b1[3]);
                        *(LAS v4u*)(lds + vrow * VS + ch * 16) = w; } }
                    __syncthreads();
                    f32x4 acc[8];
#pragma unroll
                    for (int d = 0; d < 8; ++d) acc[d] = (f32x4){0.f, 0.f, 0.f, 0.f};
#pragma unroll
                    for (int ks = 0; ks < 4; ++ks) if (ks < nks) {
                        const int s0 = 32 * ks + 8 * fq;
                        const f32x4 w0 = wreg[ks][0], w1 = wreg[ks][1];
                        float wv[8] = {w0[0], w0[1], w0[2], w0[3], w1[0], w1[1], w1[2], w1[3]};
#pragma unroll
                        for (int e = 0; e < 8; ++e) wv[e] = (s0 + e <= trow) ? wv[e] : 0.f;
                        v4u wpk; wpk.x = pk2(wv[0], wv[1]); wpk.y = pk2(wv[2], wv[3]); wpk.z = pk2(wv[4], wv[5]); wpk.w = pk2(wv[6], wv[7]);
                        const bf16x8 wfrag = __builtin_bit_cast(bf16x8, wpk);
                        LAS unsigned char* vb = lds + (32 * ks + 8 * fq + ((lane & 15) >> 2)) * VS + (4 * (lane & 3)) * 2;
#pragma unroll
                        for (int d = 0; d < 8; ++d) {
                            const s16x4 lo = __builtin_bit_cast(s16x4, __builtin_amdgcn_ds_read_tr16_b64_v4i16((LAS s16x4*)(vb + d * 32)));
                            const s16x4 hi4 = __builtin_bit_cast(s16x4, __builtin_amdgcn_ds_read_tr16_b64_v4i16((LAS s16x4*)(vb + d * 32 + 4 * VS)));
                            const bf16x8 vfrag = (bf16x8){lo[0], lo[1], lo[2], lo[3], hi4[0], hi4[1], hi4[2], hi4[3]};
                            acc[d] = __builtin_amdgcn_mfma_f32_16x16x32_bf16(vfrag, wfrag, acc[d], 0, 0, 0);
                        }
                    }
#pragma unroll
                    for (int d = 0; d < 8; ++d) { const int col = h * 128 + 16 * d + 4 * fq;
                        v2u o; o.x = pk2(bflo(uu[d].x) * (acc[d][0] + bias), bfhi(uu[d].x) * (acc[d][1] + bias)); o.y = pk2(bflo(uu[d].y) * (acc[d][2] + bias), bfhi(uu[d].y) * (acc[d][3] + bias));
                        *(v2u*)(T2 + row * LDK + col) = o; }
                }
                for (int idx = bx * 512 + tid; idx < DECB * 1024; idx += G * 512) {
                    const int sb = idx >> 10, c = (idx & 1023) * 2, h = c >> 7; const size_t r0 = (size_t)MP + sb * 8;
                    __syncthreads();
                    if (tid < 256) { const int r = tid >> 5, jj = tid & 31; const f32x2v p = *(const f32x2v*)(VST + ((r0 + r) * 32 + jj) * 2); float s1 = p.x, s2 = p.y;
#pragma unroll
                        for (int o = 1; o < 32; o <<= 1) { s1 += __builtin_bit_cast(float, __builtin_amdgcn_ds_bpermute((lane ^ o) << 2, __builtin_bit_cast(int, s1))); s2 += __builtin_bit_cast(float, __builtin_amdgcn_ds_bpermute((lane ^ o) << 2, __builtin_bit_cast(int, s2))); }
                        const float mean = s1 * (1.f / DM); if (jj == 0) ST[r] = (f32x2v){mean, 1.f / sqrtf(fmaxf(s2 * (1.f / DM) - mean * mean, 0.f) + LN_EPS)}; }
                    __syncthreads();
                    float v0[8], v1[8];
#pragma unroll
                    for (int s = 0; s < 8; ++s) { const unsigned r = *(const unsigned*)(UV + (r0 + s) * 4096 + 2048 + c); const f32x2v st = ST[s]; const float mean = st.x, rstd = st.y;
                        v0[s] = (bflo(r) - mean) * rstd * lg[c] + lb[c]; v1[s] = (bfhi(r) - mean) * rstd * lg[c + 1] + lb[c + 1];
                        float* o = OUT + OFF_CV + ((size_t)jm * MS + (r0 - MP) + s) * DM + c; o[0] = v0[s]; o[1] = v1[s]; }
#pragma unroll
                    for (int t = 0; t < 8; ++t) { float m0 = BSm[h * 128 + t], m1 = m0;
#pragma unroll
                        for (int s = 0; s < 8; ++s) if (s <= t) { const float w = WSm[(size_t)(h * 128 + t) * 128 + s]; m0 += w * v0[s]; m1 += w * v1[s]; }
                        const unsigned uu = *(const unsigned*)(UV + (r0 + t) * 4096 + c);
                        *(unsigned*)(T2 + (r0 + t) * LDK + c) = pk2(bflo(uu) * m0, bfhi(uu) * m1); }
                }
                }
            }
            PH_END();
            og_a = WS_T2; og_b = WS_AOUT + (size_t)jm * DM * LDK * 2;
        } else if (kind == 1) {
            if (PH_ON()) {
                PH_IDS(); PH_PTRS();
                const float* SP = INP(2) + (size_t)jm * DECB * 15 * DM;
                for (int rep = 0; rep < REP_POOL; ++rep) {
#define POOL_RAW(r, jj) (*(const v2u*)(XB + xb_idx((int)(r), 4 * (lane + 64 * (jj)))))
#define POOL_CV(w_) ((f32x4){bflo((w_).x), bfhi((w_).x), bflo((w_).y), bfhi((w_).y)})
#define POOL_LOAD(W, J, NH, rw) do { _Pragma("unroll") for (int h = 0; h < NH; ++h) _Pragma("unroll") for (int k = 0; k < W + 3; ++k) { const int rr = m0 - (W - 1) + k; rw[h][k] = POOL_RAW((rr < m0 - t0) ? m0 : rr, J + h); } } while (0)
#define POOL_OUT(W, J, NH, rw) do { _Pragma("unroll") for (int h = 0; h < NH; ++h) { f32x4 xf[W + 3]; _Pragma("unroll") for (int k = 0; k < W + 3; ++k) xf[k] = POOL_CV(rw[h][k]); \
                        _Pragma("unroll") for (int r = 0; r < 4; ++r) { const int t = t0 + r, cnt = (t + 1 < W) ? t + 1 : W; const f32x4 xc = xf[W - 1 + r]; f32x4 a = xc; \
                            _Pragma("unroll") for (int i = 1; i < W; ++i) a += (i < cnt) ? xf[W - 1 + r - i] : (f32x4){0.f, 0.f, 0.f, 0.f}; \
                            const f32x4 pv = a * (1.0f / (float)cnt) - xc; v2u o; o.x = pk2(pv[0], pv[1]); o.y = pk2(pv[2], pv[3]); *((v2u*)(T1 + (size_t)(m0 + r) * LDK) + lane + 64 * (J + h)) = o; \
                            if (t >= SEQ - 15) *((f32x4*)(OUT + OFF_PP + ((size_t)(jm * NBATCH + b) * 15 + (t - (SEQ - 15))) * DM) + lane + 64 * (J + h)) = xc; } } } while (0)
                for (int it = gw; it < MP / 4; it += NGW) {
                    const int m0 = 4 * it, t0 = m0 & (SEQ - 1), b = m0 >> 11;
                    v2u r2[2][5], r4[2][7]; POOL_LOAD(2, 0, 2, r2); POOL_LOAD(4, 2, 2, r4); POOL_OUT(2, 0, 2, r2);
                    v2u r8[2][11]; POOL_LOAD(8, 4, 2, r8); POOL_OUT(4, 2, 2, r4);
                    v2u ra[1][19]; POOL_LOAD(16, 6, 1, ra); POOL_OUT(8, 4, 2, r8);
                    v2u rb[1][19]; POOL_LOAD(16, 7, 1, rb); POOL_OUT(16, 6, 1, ra); POOL_OUT(16, 7, 1, rb);
                }
#undef POOL_LOAD
#undef POOL_OUT
                for (int it = gw; it < DECB * 8; it += NGW) {
                    const int sb = it >> 3, jj = it & 7, W = 2 << (jj >> 1); const size_t r0 = (size_t)MP + sb * 8;
                    f32x4 hs[15], xs[8];
#pragma unroll
                    for (int q = 0; q < 15; ++q) hs[q] = *((const f32x4*)(SP + ((size_t)sb * 15 + q) * DM) + lane + 64 * jj);
#pragma unroll
                    for (int t = 0; t < 8; ++t) { const v2u w_ = POOL_RAW(r0 + t, jj); xs[t] = POOL_CV(w_); }
                    float* ps = OUT + OFF_PS + ((size_t)(jm * DECB + sb) * 15) * DM;
#pragma unroll
                    for (int t = 0; t < 8; ++t) { const f32x4 xc = xs[t]; f32x4 a = xc;
#pragma unroll
                        for (int i = 1; i < 16; ++i) { const int q = 15 + t - i; const f32x4 xv = (q >= 15) ? xs[q >= 15 ? q - 15 : 0] : hs[q < 15 ? q : 0]; a += (i < W) ? xv : (f32x4){0.f, 0.f, 0.f, 0.f}; }
                        const f32x4 pv = a * (1.0f / (float)W) - xc; v2u o; o.x = pk2(pv[0], pv[1]); o.y = pk2(pv[2], pv[3]); *((v2u*)(T1 + (r0 + t) * LDK) + lane + 64 * jj) = o;
                        *((f32x4*)(ps + (size_t)(7 + t) * DM) + lane + 64 * jj) = xc;
                        if (t < 7) *((f32x4*)(ps + (size_t)t * DM) + lane + 64 * jj) = hs[8 + t]; }
                }
#undef POOL_RAW
#undef POOL_CV
                }
            }
            PH_END();
            og_a = WS_T1; og_b = WS_BGRP; og_ldb = 512; og_K = 512; og_gt = 2; og_gk = 512; ocs_on = 0;
        } else {
            if (PH_ON()) {
                PH_PTRS();
                pg8::Gemm g{XB, (const bf16*)(ws + WS_CIN), 32, LDK, DM, 1 << 20, 0, (long)M * 128, 128}; pg8::DpOrder S; S.init(MP / 256, 24, G, bx, false);
                pg8::EpiConvIn E{UV, OUT + OFF_CP + (size_t)jm * NBATCH * 2 * DM, OUT + OFF_CS + (size_t)jm * DECB * 2 * DM};
                for (int rep = 0; rep < REP_MG; ++rep)
                pg8::gemm_phase<pg8::EpiConvIn, pg8::DpOrder, true, true, 1>(lds + RING_OFF, g, S, E, opaque_tid(wave_id));
            }
            PH_END();
            if (PH_ON()) {
                PH_IDS(); PH_PTRS();
                const float* HC = INP(3) + (size_t)jm * DECB * 2 * DM; const float* WC = INP(23) + (size_t)jm * 3 * DM;
                for (int rep = 0; rep < REP_CG; ++rep)
                for (int m = gw; m < M; m += NGW) {
                    int t, sb = 0; if (m < MP) t = m & (SEQ - 1); else { const int lr = m - MP; sb = lr >> 3; t = lr & 7; }
#pragma unroll
                    for (int j = 0; j < 4; ++j) { const int c = 8 * (lane + 64 * j);
                        const v4u zb = *(const v4u*)(UV + (size_t)m * 4096 + 2048 + c), bb = *(const v4u*)(UV + (size_t)m * 4096 + c);
                        float z[8] = {bflo(zb.x), bfhi(zb.x), bflo(zb.y), bfhi(zb.y), bflo(zb.z), bfhi(zb.z), bflo(zb.w), bfhi(zb.w)};
                        float bg[8] = {bflo(bb.x), bfhi(bb.x), bflo(bb.y), bfhi(bb.y), bflo(bb.z), bfhi(bb.z), bflo(bb.w), bfhi(bb.w)};
                        float z1[8], z2[8];
                        if (t >= 1) { const v4u r = *(const v4u*)(UV + (size_t)(m - 1) * 4096 + 2048 + c);
                            z1[0] = bflo(r.x); z1[1] = bfhi(r.x); z1[2] = bflo(r.y); z1[3] = bfhi(r.y); z1[4] = bflo(r.z); z1[5] = bfhi(r.z); z1[6] = bflo(r.w); z1[7] = bfhi(r.w); }
                        else if (m >= MP) { const float* hp = HC + ((size_t)sb * 2 + 1) * DM + c;
#pragma unroll
                            for (int e = 0; e < 8; ++e) z1[e] = hp[e]; }
                        else {
#pragma unroll
                            for (int e = 0; e < 8; ++e) z1[e] = 0.f; }
                        if (t >= 2) { const v4u r = *(const v4u*)(UV + (size_t)(m - 2) * 4096 + 2048 + c);
                            z2[0] = bflo(r.x); z2[1] = bfhi(r.x); z2[2] = bflo(r.y); z2[3] = bfhi(r.y); z2[4] = bflo(r.z); z2[5] = bfhi(r.z); z2[6] = bflo(r.w); z2[7] = bfhi(r.w); }
                        else if (m >= MP) { const float* hp = HC + ((size_t)sb * 2 + t) * DM + c;
#pragma unroll
                            for (int e = 0; e < 8; ++e) z2[e] = hp[e]; }
                        else {
#pragma unroll
                            for (int e = 0; e < 8; ++e) z2[e] = 0.f; }
                        float o[8];
#pragma unroll
                        for (int e = 0; e < 8; ++e) o[e] = bg[e] * (WC[2 * DM + c + e] * z[e] + WC[DM + c + e] * z1[e] + WC[c + e] * z2[e]);
                        v4u w; w.x = pk2(o[0], o[1]); w.y = pk2(o[2], o[3]); w.z = pk2(o[4], o[5]); w.w = pk2(o[6], o[7]);
                        *(v4u*)(T1 + (size_t)m * LDK + c) = w; }
                }
            }
            PH_END();
            og_a = WS_T1; og_b = WS_COUT;
        }
        if (PH_ON()) {
            PH_PTRS();
            const pg8::Gemm og{(const bf16*)(ws + og_a), (const bf16*)(ws + og_b), og_lda, og_ldb, og_K, og_gt, og_gk, og_ksa, og_ksb};
#if FUSE_LN
            const int gi = (sub == 0) ? 8 : (sub == 1 ? 10 : 12);
            pg8::PanelOrder S{bx};
            pg8::EpiResidLN E{step == 11 ? X : nullptr, ocs_on ? INP(21) + (size_t)jm * DM : nullptr, os,
                              INP(gi) + (size_t)L * DM, INP(gi + 1) + (size_t)L * DM, XB, (unsigned long long*)(ws + WS_SLOT), ctl + CW_LN + step * LN_BANK, ctl + CW_TMO};
            pg8::gemm_phase<pg8::EpiResidLN, pg8::PanelOrder, true, true, 1>(lds + RING_OFF, og, S, E, opaque_tid(wave_id));
#else
            pg8::DpOrder S; S.init(M / 256, 8, G, bx, SUB_ON);
            pg8::EpiResid E{step == 0 ? INP(0) : X, step == 0 ? INP(1) : X + (size_t)MP * DM, X, ocs_on ? INP(21) + (size_t)jm * DM : nullptr, os};
            for (int rep = 0; rep < (step == 0 ? REP_DOWN0 : 1); ++rep, (rep < (step == 0 ? REP_DOWN0 : 1) ? xcd_barrier(bar, opaque_tid(wave_id)) : (void)0))
            { pg8::gemm_phase<pg8::EpiResid, pg8::DpOrder, true, true>(lds + RING_OFF, og, S, E, opaque_tid(wave_id)); pg8::gemm_sub_phase<pg8::EpiResid, pg8::DpOrder>(lds + RING_OFF, og, S, E, opaque_tid(wave_id)); }
#endif
        }
        PH_END();
#if !FUSE_LN
        if (PH_ON()) {
            PH_IDS(); PH_PTRS();
            const int gi = (sub == 0) ? 8 : (sub == 1 ? 10 : 12);
            const float* lg = INP(gi) + (size_t)L * DM; const float* lb = INP(gi + 1) + (size_t)L * DM;
            for (int rep = 0; rep < REP_LN; ++rep)
            for (int m = gw; m < M; m += NGW) {
                const bool dummy = rep < REP_LN - 1;
                f32x4* xr = (f32x4*)(X + (size_t)m * DM) + lane; f32x4* xw = dummy ? (f32x4*)((float*)(ws + WS_PART) + (size_t)m * DM) + lane : xr;
                f32x4 v[8]; float s = 0.f;
#pragma unroll
                for (int j = 0; j < 8; ++j) { v[j] = xr[64 * j]; s += (v[j].x + v[j].y) + (v[j].z + v[j].w); }
                const float mean = wave_sum(s, lane) * (1.f / DM); float s2 = 0.f;
#pragma unroll
                for (int j = 0; j < 8; ++j) { v[j] = v[j] - mean; s2 += (v[j].x * v[j].x + v[j].y * v[j].y) + (v[j].z * v[j].z + v[j].w * v[j].w); }
                const float rstd = 1.f / sqrtf(wave_sum(s2, lane) * (1.f / DM) + LN_EPS);
                v2u* o8 = (v2u*)((dummy ? T2 : XB) + (size_t)m * LDK) + lane;
#pragma unroll
                for (int j = 0; j < 8; ++j) { const f32x4 gg = *((const f32x4*)lg + lane + 64 * j), bb = *((const f32x4*)lb + lane + 64 * j);
                    const f32x4 o = v[j] * rstd * gg + bb; xw[64 * j] = o; v2u w; w.x = pk2(o.x, o.y); w.y = pk2(o.z, o.w); o8[64 * j] = w; }
            }
        }
        PH_END();
#endif
    }
#undef PH_ON
#undef PH_END
#undef PH_IDS
#undef PH_PTRS
#undef INP
}

constexpr int N_PHASES = 1 + 8 * 3 + (4 + 3 + 4 + 4) - (FUSE_LN ? 12 : 0);

extern "C" void kernel_launch(void* const* d_in, const int* in_sizes, int n_in, void* d_out, int out_size, void* d_ws, size_t ws_size, hipStream_t stream) {
    static int grid = 0;
    if (grid == 0) {
        if (n_in != 25 || (size_t)out_size != OUT_TOTAL || ws_size < WS_END) { fprintf(stderr, "kernel_launch: unexpected shapes: n_in %d out %d ws %zu (need %zu)\n", n_in, out_size, ws_size, (size_t)WS_END); grid = -1; return; }
        int dev = 0, cus = 0, per_cu = 0;
        if (hipGetDevice(&dev) != hipSuccess || hipDeviceGetAttribute(&cus, hipDeviceAttributeMultiprocessorCount, dev) != hipSuccess) { grid = -1; return; }
        if (hipFuncSetAttribute((const void*)fwd_kernel, hipFuncAttributeMaxDynamicSharedMemorySize, LDS_BYTES) != hipSuccess) { fprintf(stderr, "kernel_launch: hipFuncSetAttribute failed\n"); grid = -1; return; }
        if (hipOccupancyMaxActiveBlocksPerMultiprocessor(&per_cu, (const void*)fwd_kernel, NWAVES * 64, LDS_BYTES) != hipSuccess || per_cu < 1)
            fprintf(stderr, "kernel_launch: note: occupancy query reports %d workgroups per CU\n", per_cu);
        (void)hipGetLastError();
        grid = cus;
    }
    if (grid < 0) return;
    if (hipMemsetAsync((char*)d_ws + WS_CTL, 0, CTL_ZERO_BYTES, stream) != hipSuccess) { fprintf(stderr, "kernel_launch: memset failed\n"); return; }
    Args a{};
    for (int i = 0; i < 25; ++i) a.in[i] = (const float*)d_in[i];
    a.out = (float*)d_out; a.ws = (unsigned char*)d_ws;
#if MK_PER_PHASE
    for (int p = 0; p < N_PHASES; ++p) { a.ph_lo = p; a.ph_hi = p + 1; hipLaunchKernelGGL(fwd_kernel, dim3(grid), dim3(NWAVES * 64), LDS_BYTES, stream, a); }
#else
    a.ph_lo = 0; a.ph_hi = N_PHASES;
    hipLaunchKernelGGL(fwd_kernel, dim3(grid), dim3(NWAVES * 64), LDS_BYTES, stream, a);
#endif
    const hipError_t le = hipPeekAtLastError();
    if (le != hipSuccess) fprintf(stderr, "kernel_launch: launch failed: %s\n", hipGetErrorName(le));
}
```

```cpp
#include <hip/hip_runtime.h>
#include <cstdio>
#include <cstdint>

#define PG8_BK32 1
#define PG8_ASYM 0
#define FUSE_LN 1
#define SUB_ON 1
#define REP_PRO 1
#define REP_UP 1
#define REP_DOWN0 1
#define REP_LN 1
#define REP_LNV 1
#define REP_BAR 1
#define REP_MG 1
#define REP_MIX 1
#define REP_POOL 1
#define REP_CG 1
#ifndef MK_PER_PHASE
#define MK_PER_PHASE 0
#endif

constexpr int DM = 2048, SEQ = 2048, NBATCH = 4, DECB = 128, DECS = 8, DFF = 5504;
constexpr int MP = NBATCH * SEQ, MS = DECB * DECS, M = MP + MS;
constexpr int LDK = DM + 64;
constexpr float ALPHA = 1.6817928305074290861f;
constexpr float LN_EPS = 1e-5f;
constexpr size_t OFF_Y = 0, OFF_PP = (size_t)M * DM, OFF_PS = OFF_PP + (size_t)NBATCH * 15 * DM, OFF_CP = OFF_PS + (size_t)DECB * 15 * DM,
                 OFF_CS = OFF_CP + (size_t)NBATCH * 2 * DM, OFF_CV = OFF_CS + (size_t)DECB * 2 * DM, OUT_TOTAL = OFF_CV + (size_t)2 * MS * DM;

namespace pg8 {
#define PG8_LAS __attribute__((address_space(3)))
typedef unsigned short bf16_t;
typedef short bf16x8 __attribute__((ext_vector_type(8)));
typedef float f32x4 __attribute__((ext_vector_type(4)));
typedef float f32x2 __attribute__((ext_vector_type(2)));
typedef unsigned u32x4 __attribute__((ext_vector_type(4)));
typedef unsigned u32x2 __attribute__((ext_vector_type(2)));
constexpr int BM = 256, BK = 64, HALF = 128, HTB = HALF * BK * 2  , STAGE_BYTES = 8 * HTB, NXCD = 8, WGM = 4;

__host__ __device__ __forceinline__ int lds_byte(int r, int c) { const int st = (r >> 4) * 2 + (c >> 5), rr = r & 15, cc = c & 31, ob = rr * 64 + cc * 2; return st * 1024 + (ob ^ (((ob >> 9) & 1) << 5)); }
__host__ __device__ __forceinline__ void stage_rc(int b, int& R, int& C) { const int st = b / 1024, sb = b % 1024, swz = sb ^ (((sb >> 9) & 1) << 5); R = (st >> 1) * 16 + swz / 64; C = (st & 1) * 32 + (swz % 64) / 2; }
__host__ __device__ __forceinline__ int perm32(int rho) { const int n = rho >> 4, i = rho & 15; return 8 * (i >> 2) + 4 * n + (i & 3); }

struct Unit { int pm, pn; };
struct Gemm { const bf16_t* A; const bf16_t* Bt; int lda, ldb, K, grp_tiles, grp_koff; long ksa, ksb; };

struct DpOrder {
    int nM, nN, nx, j, base, Tx, Rdp, rem;
    __device__ __forceinline__ void init(int nM_, int nN_, int G, int bx, bool sub) {
        asm volatile("" : "+s"(bx), "+s"(G));
        nM = nM_; nN = nN_; const int nwg = nM * nN, NX = (G % NXCD == 0) ? NXCD : 1; nx = G / NX; const int x = bx % NX; j = bx / NX;
        const int q = nwg / NX, r = nwg % NX; Tx = q + (x < r ? 1 : 0); base = x < r ? x * (q + 1) : r * (q + 1) + (x - r) * q;
        Rdp = Tx / nx; rem = Tx % nx; if (!sub && rem) { ++Rdp; rem = 0; }
        Tx = __builtin_amdgcn_readfirstlane(Tx); base = __builtin_amdgcn_readfirstlane(base); Rdp = __builtin_amdgcn_readfirstlane(Rdp); rem = __builtin_amdgcn_readfirstlane(rem); j = __builtin_amdgcn_readfirstlane(j); nx = __builtin_amdgcn_readfirstlane(nx);
    }
    __device__ __forceinline__ void tile(int wgid, Unit& u) const { const int nig = WGM * nN, gid = wgid / nig, fm = gid * WGM, gsz = (nM - fm) < WGM ? (nM - fm) : WGM;
        u.pm = __builtin_amdgcn_readfirstlane(fm + ((wgid % nig) % gsz)); u.pn = __builtin_amdgcn_readfirstlane((wgid % nig) / gsz); }
    __device__ __forceinline__ bool next(int i, Unit& u) const { if (i >= Rdp || nx * i + j >= Tx) return false; tile(base + nx * i + j, u); return true; }
    __device__ __forceinline__ bool next_sub(int i, Unit& u, int& sub) const { const int su = nx * i + j; if (su >= 8 * rem) return false; tile(base + Rdp * nx + (su >> 3), u); sub = su & 7; return true; }
    __device__ __forceinline__ bool hasx(const Unit&) const { return true; }
    __device__ __forceinline__ void a_ready(const Unit&) const {}
    __device__ __forceinline__ void done(const Unit&) const {}
};

__device__ __forceinline__ unsigned cvt_pk_bf16(float lo, float hi) { unsigned r; asm volatile("v_cvt_pk_bf16_f32 %0, %1, %2" : "=v"(r) : "v"(lo), "v"(hi)); return r; }
__device__ __forceinline__ f32x2 gelu_pk(f32x2 v) {
    const f32x2 av = __builtin_elementwise_abs(v), d = av * 0.2316418882f + 1.0f;
    f32x2 t; t.x = __builtin_amdgcn_rcpf(d.x); t.y = __builtin_amdgcn_rcpf(d.y);
    f32x2 q = t * 0.5307027145f + (-0.7265760135f); q = q * t + 0.7107068705f; q = q * t + (-0.142248368f); q = q * t + 0.127414796f; q = q * t;
    const f32x2 s = (v * v) * (-0.72134752044f);
    f32x2 e; e.x = __builtin_amdgcn_exp2f(s.x); e.y = __builtin_amdgcn_exp2f(s.y);
    const f32x2 m = v * (q * e), r = v - m;
    f32x2 o; o.x = v.x < 0.f ? m.x : r.x; o.y = v.y < 0.f ? m.y : r.y; return o;
}
__device__ __forceinline__ float silu_f(float g) { return g * __builtin_amdgcn_rcpf(1.0f + __builtin_amdgcn_exp2f(g * -1.4426950408889634f)); }
__device__ __forceinline__ u32x4 pack8(const f32x4& a, const f32x4& b) { u32x4 w; w.x = cvt_pk_bf16(a[0], a[1]); w.y = cvt_pk_bf16(a[2], a[3]); w.z = cvt_pk_bf16(b[0], b[1]); w.w = cvt_pk_bf16(b[2], b[3]); return w; }
__device__ __forceinline__ __amdgpu_buffer_rsrc_t wt_rsrc(const void* base) { return __builtin_amdgcn_make_buffer_rsrc((void*)base, 0, 0x7fffffff, 0x00020000); }
#define PG8_EPI_CALL() \
    __device__ __forceinline__ void operator()(const f32x4 (&acc)[2][2][4][2], const Unit& u, int wr, int wc, int fr, int fq) const { \
        _Pragma("unroll") for (int ai = 0; ai < 2; ++ai) _Pragma("unroll") for (int m = 0; m < 4; ++m) \
            grp(acc[ai][0][m][0], acc[ai][0][m][1], acc[ai][1][m][0], acc[ai][1][m][1], u, u.pm * BM + ai * HALF + wr * 64 + m * 16 + fr, wc, fq); }

template <int ACT> struct EpiBf16 {
    static constexpr bool PERM = true, AFTER_DRAIN = false, INIT_ACC = false;
    bf16_t* O; int ldc; float* vst;
    __device__ __forceinline__ void grp(f32x4 v00, f32x4 v01, f32x4 v10, f32x4 v11, const Unit& u, int row, int wc, int fq) const {
        bf16_t* rowp = O + (size_t)row * ldc + u.pn * BM + wc * 32 + 8 * fq;
        if (ACT == 1) { f32x2 a = gelu_pk((f32x2){v00[0], v00[1]}), b = gelu_pk((f32x2){v00[2], v00[3]}), c = gelu_pk((f32x2){v01[0], v01[1]}), d = gelu_pk((f32x2){v01[2], v01[3]});
            v00 = (f32x4){a.x, a.y, b.x, b.y}; v01 = (f32x4){c.x, c.y, d.x, d.y};
            a = gelu_pk((f32x2){v10[0], v10[1]}); b = gelu_pk((f32x2){v10[2], v10[3]}); c = gelu_pk((f32x2){v11[0], v11[1]}); d = gelu_pk((f32x2){v11[2], v11[3]});
            v10 = (f32x4){a.x, a.y, b.x, b.y}; v11 = (f32x4){c.x, c.y, d.x, d.y}; }
        *(u32x4*)rowp = pack8(v00, v01); *(u32x4*)(rowp + HALF) = pack8(v10, v11);
        if (vst && u.pn >= 8) { const int lane = (row & 15) + 16 * fq;
            float s1 = ((v00[0] + v00[1]) + (v00[2] + v00[3])) + ((v01[0] + v01[1]) + (v01[2] + v01[3])) + ((v10[0] + v10[1]) + (v10[2] + v10[3])) + ((v11[0] + v11[1]) + (v11[2] + v11[3]));
            float s2 = ((v00[0] * v00[0] + v00[1] * v00[1]) + (v00[2] * v00[2] + v00[3] * v00[3])) + ((v01[0] * v01[0] + v01[1] * v01[1]) + (v01[2] * v01[2] + v01[3] * v01[3]))
                     + ((v10[0] * v10[0] + v10[1] * v10[1]) + (v10[2] * v10[2] + v10[3] * v10[3])) + ((v11[0] * v11[0] + v11[1] * v11[1]) + (v11[2] * v11[2] + v11[3] * v11[3]));
#pragma unroll
            for (int o = 16; o < 64; o <<= 1) { s1 += __builtin_bit_cast(float, __builtin_amdgcn_ds_bpermute((lane ^ o) << 2, __builtin_bit_cast(int, s1))); s2 += __builtin_bit_cast(float, __builtin_amdgcn_ds_bpermute((lane ^ o) << 2, __builtin_bit_cast(int, s2))); }
            if (fq == 0) *(f32x2*)(vst + (((size_t)row * 8 + (u.pn - 8)) * 4 + wc) * 2) = (f32x2){s1, s2}; }
    }
    PG8_EPI_CALL()
};
struct EpiSwiGLU {
    static constexpr bool PERM = true, AFTER_DRAIN = false, INIT_ACC = false;
    bf16_t* O; int ldc;
    __device__ __forceinline__ void grp(f32x4 g0, f32x4 g1, f32x4 u0, f32x4 u1, const Unit& u, int row, int wc, int fq) const {
        f32x4 h0, h1;
#pragma unroll
        for (int e = 0; e < 4; ++e) { h0[e] = silu_f(g0[e]) * u0[e]; h1[e] = silu_f(g1[e]) * u1[e]; }
        const int col = u.pn * HALF + wc * 32 + 8 * fq;
        *(u32x4*)(O + ((size_t)(col >> 6) * M + row) * 64 + (col & 63)) = pack8(h0, h1);
    }
    PG8_EPI_CALL()
};
struct EpiConvIn {
    static constexpr bool PERM = true, AFTER_DRAIN = false, INIT_ACC = false;
    bf16_t* BZ; float* out_cp; float* out_cs;
    __device__ __forceinline__ void grp(f32x4 v00, f32x4 v01, f32x4 v10, f32x4 v11, const Unit& u, int row, int wc, int fq) const {
        if (u.pn < 8) { bf16_t* rowp = BZ + (size_t)row * 4096 + u.pn * BM + wc * 32 + 8 * fq; *(u32x4*)rowp = pack8(v00, v01); *(u32x4*)(rowp + HALF) = pack8(v10, v11); }
        else { const int col0 = (u.pn - 8) * HALF + wc * 32 + 8 * fq; const f32x4 z0 = v00 * v10, z1 = v01 * v11;
            *(u32x4*)(BZ + (size_t)row * 4096 + 2048 + col0) = pack8(z0, z1);
            if (row < MP) { const int t = row & (SEQ - 1);
                if (t >= SEQ - 2) { float* o = out_cp + ((size_t)(row >> 11) * 2 + (t - (SEQ - 2))) * DM + col0; *(f32x4*)o = z0; *(f32x4*)(o + 4) = z1; } }
            else { const int lr = row - MP, t = lr & 7;
                if (t >= 6) { float* o = out_cs + ((size_t)(lr >> 3) * 2 + (t - 6)) * DM + col0; *(f32x4*)o = z0; *(f32x4*)(o + 4) = z1; } } }
    }
    PG8_EPI_CALL()
};
struct EpiResid {
    static constexpr bool PERM = false, AFTER_DRAIN = false, INIT_ACC = false;
    const float* res_p; const float* res_s; float* out; const float* colscale; float s;
    __device__ __forceinline__ void grp(f32x4 v00, f32x4 v01, f32x4 v10, f32x4 v11, const Unit& u, int row, int wc, int fq) const {
        const int col0 = u.pn * BM + wc * 32 + 4 * fq;
        const float* rp = ((row < MP) ? res_p + (size_t)row * DM : res_s + (size_t)(row - MP) * DM) + col0; float* op = out + (size_t)row * DM + col0;
        f32x4 c00 = (f32x4){s, s, s, s}, c01 = c00, c10 = c00, c11 = c00;
        if (colscale) { c00 = *(const f32x4*)(colscale + col0) * s; c01 = *(const f32x4*)(colscale + col0 + 16) * s; c10 = *(const f32x4*)(colscale + col0 + HALF) * s; c11 = *(const f32x4*)(colscale + col0 + HALF + 16) * s; }
        const f32x4 r00 = *(const f32x4*)rp, r01 = *(const f32x4*)(rp + 16), r10 = *(const f32x4*)(rp + HALF), r11 = *(const f32x4*)(rp + HALF + 16);
        *(f32x4*)op = r00 * ALPHA + v00 * c00; *(f32x4*)(op + 16) = r01 * ALPHA + v01 * c01; *(f32x4*)(op + HALF) = r10 * ALPHA + v10 * c10; *(f32x4*)(op + HALF + 16) = r11 * ALPHA + v11 * c11;
    }
    PG8_EPI_CALL()
};

struct UpOrder {
    int bx, part;
    __device__ __forceinline__ void unit(int r, Unit& u) const { const int x = bx & 7, i = 32 * r + (bx >> 3);
        if (i < 172) { u.pm = 4 * x + (i & 3); u.pn = i >> 2; } else { u.pm = 32 + (x >> 1); u.pn = (x & 1) * 20 + (i - 172); } }
    __device__ __forceinline__ bool host() const { return (bx >> 3) < 12; }
    __device__ __forceinline__ bool next(int r, Unit& u) const {
        if (part == 0) { if (r >= 6 || (r == 5 && host())) return false; unit(r, u); return true; }
        if (r > 0 || !host()) return false; unit(5, u); return true; }
    __device__ __forceinline__ bool hasx(const Unit&) const { return true; }
    __device__ __forceinline__ void a_ready(const Unit&) const {}
    __device__ __forceinline__ void done(const Unit&) const {}
};
struct PanelOrder {
    int bx;
    __device__ __forceinline__ bool next(int i, Unit& u) const { if (i) return false; const int x = bx & 7, j = bx >> 3; u.pm = 4 * x + (j >> 3); u.pn = j & 7; return true; }
    __device__ __forceinline__ bool hasx(const Unit&) const { return true; }
    __device__ __forceinline__ void a_ready(const Unit&) const {}
    __device__ __forceinline__ void done(const Unit&) const {}
};
struct EpiResidLN {
    static constexpr bool PERM = true, AFTER_DRAIN = true, INIT_ACC = true;
    float* out; const float* colscale; float s;
    const float* lng; const float* lnb; bf16_t* xb; unsigned long long* slots; unsigned* cnt; unsigned* tmo; unsigned tag;
    typedef __attribute__((address_space(1))) unsigned gu32_t; typedef __attribute__((address_space(1))) unsigned long long gu64_t;
    static __device__ __forceinline__ float lx(float v, int lane, int o) { return __builtin_bit_cast(float, __builtin_amdgcn_ds_bpermute((lane ^ o) << 2, __builtin_bit_cast(int, v))); }
    __device__ __forceinline__ void wait_cnt(unsigned* c, unsigned want, int lane, PG8_LAS unsigned* flag) const {
        unsigned sp = 0; bool dead = false;
        while ((unsigned)__builtin_amdgcn_readfirstlane(__hip_atomic_load((gu32_t*)c, __ATOMIC_RELAXED, __HIP_MEMORY_SCOPE_AGENT)) < want) {
            __builtin_amdgcn_s_sleep(1);
            if ((++sp & 255u) == 0u) { if (__builtin_amdgcn_readfirstlane(__hip_atomic_load((gu32_t*)tmo, __ATOMIC_RELAXED, __HIP_MEMORY_SCOPE_AGENT))) { dead = true; break; }
                if (sp > (1u << 18)) { if (lane == 0) __hip_atomic_fetch_add((gu32_t*)tmo, 1u, __ATOMIC_RELAXED, __HIP_MEMORY_SCOPE_AGENT); dead = true; break; } } }
        if (lane == 0) flag[0] = dead ? 1u : 0u;
    }
    __device__ __forceinline__ void ldres(u32x2 (&r)[4], int row, int col0) const { const __amdgpu_buffer_rsrc_t rs = wt_rsrc(xb); const unsigned o = (unsigned)(((col0 >> 5) * M + row) * 32 + (col0 & 31)) * 2u;
        const u32x4 a = __builtin_amdgcn_raw_buffer_load_b128(rs, o, 0, 0), b = __builtin_amdgcn_raw_buffer_load_b128(rs, o, 4u * M * 64u, 0);
        r[0] = (u32x2){a.x, a.y}; r[1] = (u32x2){a.z, a.w}; r[2] = (u32x2){b.x, b.y}; r[3] = (u32x2){b.z, b.w}; }
    static __device__ __forceinline__ f32x4 bf4(u32x2 w) { return (f32x4){__uint_as_float(w.x << 16), __uint_as_float(w.x & 0xffff0000u), __uint_as_float(w.y << 16), __uint_as_float(w.y & 0xffff0000u)}; }
    __device__ __forceinline__ void init_load(u32x2 (&rs)[9][4], const Unit& u, int wr, int wc, int fr, int fq) const { const int col0 = u.pn * BM + wc * 32 + 8 * fq;
#pragma unroll
        for (int ai = 0; ai < 2; ++ai)
#pragma unroll
            for (int m = 0; m < 4; ++m) ldres(rs[ai * 4 + m], u.pm * BM + ai * HALF + wr * 64 + m * 16 + fr, col0);
        ldres(rs[8], MP + 32 * u.pm + wr * 16 + fr, col0); }
    __device__ __forceinline__ void init_cvt(f32x4 (&acc)[2][2][4][2], f32x4 (&accx)[2][2], const u32x2 (&rs)[9][4]) const { const float k = ALPHA / s;
#pragma unroll
        for (int ai = 0; ai < 2; ++ai)
#pragma unroll
            for (int m = 0; m < 4; ++m) { acc[ai][0][m][0] = bf4(rs[ai * 4 + m][0]) * k; acc[ai][0][m][1] = bf4(rs[ai * 4 + m][1]) * k; acc[ai][1][m][0] = bf4(rs[ai * 4 + m][2]) * k; acc[ai][1][m][1] = bf4(rs[ai * 4 + m][3]) * k; }
        accx[0][0] = bf4(rs[8][0]) * k; accx[0][1] = bf4(rs[8][1]) * k; accx[1][0] = bf4(rs[8][2]) * k; accx[1][1] = bf4(rs[8][3]) * k; }
    __device__ __forceinline__ void yrow(f32x4& v00, f32x4& v01, f32x4& v10, f32x4& v11, int lane, float& mw, float& q) const {
        v00 = v00 * s; v01 = v01 * s; v10 = v10 * s; v11 = v11 * s;
        float t = ((v00[0] + v00[1]) + (v00[2] + v00[3])) + ((v01[0] + v01[1]) + (v01[2] + v01[3])) + ((v10[0] + v10[1]) + (v10[2] + v10[3])) + ((v11[0] + v11[1]) + (v11[2] + v11[3]));
        t += lx(t, lane, 16); t += lx(t, lane, 32); mw = t * (1.0f / 64.0f);
        const f32x4 d0 = v00 - mw, d1 = v01 - mw, d2 = v10 - mw, d3 = v11 - mw;
        float u = ((d0[0] * d0[0] + d0[1] * d0[1]) + (d0[2] * d0[2] + d0[3] * d0[3])) + ((d1[0] * d1[0] + d1[1] * d1[1]) + (d1[2] * d1[2] + d1[3] * d1[3]))
                + ((d2[0] * d2[0] + d2[1] * d2[1]) + (d2[2] * d2[2] + d2[3] * d2[3])) + ((d3[0] * d3[0] + d3[1] * d3[1]) + (d3[2] * d3[2] + d3[3] * d3[3]));
        u += lx(u, lane, 16); u += lx(u, lane, 32); q = u;
    }
    __device__ __forceinline__ void xrow(const f32x4& v00, const f32x4& v01, const f32x4& v10, const f32x4& v11, int row, int col0, f32x2 sr, const f32x4 (&gg)[4], const f32x4 (&bb)[4]) const {
        const __amdgpu_buffer_rsrc_t rb = wt_rsrc(xb), ro = wt_rsrc(out); const unsigned bo = (unsigned)(((col0 >> 5) * M + row) * 32 + (col0 & 31)) * 2u, oo = (unsigned)(row * DM + col0) * 4u;
        const f32x4 o00 = (v00 - sr.x) * sr.y * gg[0] + bb[0], o01 = (v01 - sr.x) * sr.y * gg[1] + bb[1], o10 = (v10 - sr.x) * sr.y * gg[2] + bb[2], o11 = (v11 - sr.x) * sr.y * gg[3] + bb[3];
        if (out) { __builtin_amdgcn_raw_buffer_store_b128(__builtin_bit_cast(u32x4, o00), ro, oo, 0, 2); __builtin_amdgcn_raw_buffer_store_b128(__builtin_bit_cast(u32x4, o01), ro, oo + 16, 0, 2);
                   __builtin_amdgcn_raw_buffer_store_b128(__builtin_bit_cast(u32x4, o10), ro, oo + HALF * 4, 0, 2); __builtin_amdgcn_raw_buffer_store_b128(__builtin_bit_cast(u32x4, o11), ro, oo + HALF * 4 + 16, 0, 2); }
        else { __builtin_amdgcn_raw_buffer_store_b128(pack8(o00, o01), rb, bo, 0, 0); __builtin_amdgcn_raw_buffer_store_b128(pack8(o10, o11), rb, bo, 4u * M * 64u, 0); }
    }
    __device__ __forceinline__ void exchange(int rows, int row0, int xrow0, int pn, unsigned* counter, unsigned want, PG8_LAS unsigned char* lds, int wid, int lane) const {
        typedef float f32x2v __attribute__((ext_vector_type(2)));
        PG8_LAS f32x2v* P = (PG8_LAS f32x2v*)lds; PG8_LAS f32x2v* S = (PG8_LAS f32x2v*)(lds + 9216); PG8_LAS unsigned* flag = (PG8_LAS unsigned*)(lds + 9216 + 2304);
        asm volatile("s_waitcnt lgkmcnt(0)" ::: "memory"); __builtin_amdgcn_s_barrier(); asm volatile("" ::: "memory");
        const int row = wid * 36 + lane; const bool mine = lane < 36 && row < rows; const size_t grow = (size_t)((row < 256) ? row0 + row : xrow0 + row - 256);
        if (mine) { const f32x2v a = P[row * 4 + 0], b = P[row * 4 + 1], c = P[row * 4 + 2], d = P[row * 4 + 3];
            const float mt = (a.x + b.x + c.x + d.x) * 0.25f; const float da = a.x - mt, db = b.x - mt, dc = c.x - mt, dd = d.x - mt;
            const float m2 = (a.y + b.y) + (c.y + d.y) + 64.0f * ((da * da + db * db) + (dc * dc + dd * dd));
            __hip_atomic_store((gu64_t*)(slots + grow * 8 + pn), ((unsigned long long)((__float_as_uint(m2) & ~31u) | tag) << 32) | __float_as_uint(mt), __ATOMIC_RELAXED, __HIP_MEMORY_SCOPE_AGENT); }
        if (lane == 0 && wid * 36 < rows) __hip_atomic_fetch_add((gu32_t*)counter, 1u, __ATOMIC_RELAXED, __HIP_MEMORY_SCOPE_AGENT);
        if (wid == 0) wait_cnt(counter, want, lane, flag);
        asm volatile("s_waitcnt vmcnt(0) lgkmcnt(0)" ::: "memory"); __builtin_amdgcn_s_barrier(); asm volatile("" ::: "memory");
        if (mine) { const unsigned long long* sl = slots + grow * 8; float mt[8], m2[8]; float ms = 0.f;
#pragma unroll
            for (int t = 0; t < 8; ++t) { unsigned long long w = __hip_atomic_load((gu64_t*)(sl + t), __ATOMIC_RELAXED, __HIP_MEMORY_SCOPE_AGENT);
                for (unsigned sp = 0; (((unsigned)(w >> 32)) & 31u) != tag && sp < (1u << 16); ++sp) { __builtin_amdgcn_s_sleep(1); w = __hip_atomic_load((gu64_t*)(sl + t), __ATOMIC_RELAXED, __HIP_MEMORY_SCOPE_AGENT); }
                if ((((unsigned)(w >> 32)) & 31u) != tag) w = 0x7fc000007fc00000ull;
                mt[t] = __uint_as_float((unsigned)w); m2[t] = __uint_as_float(((unsigned)(w >> 32)) & ~31u); ms += mt[t]; }
            const float mean = ms * 0.125f; float q = 0.f;
#pragma unroll
            for (int t = 0; t < 8; ++t) { const float dm = mt[t] - mean; q += m2[t] + 256.0f * dm * dm; }
            S[row] = (f32x2v){mean, (flag[0] != 0u) ? __builtin_nanf("") : 1.0f / sqrtf(q * (1.0f / DM) + LN_EPS)}; }
        asm volatile("s_waitcnt lgkmcnt(0)" ::: "memory"); __builtin_amdgcn_s_barrier(); asm volatile("" ::: "memory");
    }
    __device__ __forceinline__ void fused_tile(f32x4 (&acc)[2][2][4][2], f32x4 (&accx)[2][2], const Unit& u, int wr, int wc, int fr, int fq, PG8_LAS unsigned char* lds, int wid, int lane) const {
        typedef float f32x2v __attribute__((ext_vector_type(2)));
        PG8_LAS f32x2v* P = (PG8_LAS f32x2v*)lds; const PG8_LAS f32x2v* S = (const PG8_LAS f32x2v*)(lds + 9216);
        const int col0 = u.pn * BM + wc * 32 + 8 * fq, xr0 = MP + 32 * u.pm, xl = 256 + wr * 16 + fr;
#pragma unroll
        for (int ai = 0; ai < 2; ++ai)
#pragma unroll
            for (int m = 0; m < 4; ++m) { const int rl = ai * HALF + wr * 64 + m * 16 + fr; float mw, q;
                yrow(acc[ai][0][m][0], acc[ai][0][m][1], acc[ai][1][m][0], acc[ai][1][m][1], lane, mw, q);
                if (fq == 0) P[rl * 4 + wc] = (f32x2v){mw, q}; }
        { float mw, q; yrow(accx[0][0], accx[0][1], accx[1][0], accx[1][1], lane, mw, q); if (fq == 0) P[xl * 4 + wc] = (f32x2v){mw, q}; }
        f32x4 gg[4], bb[4];
        gg[0] = *(const f32x4*)(lng + col0); gg[1] = *(const f32x4*)(lng + col0 + 4); gg[2] = *(const f32x4*)(lng + col0 + HALF); gg[3] = *(const f32x4*)(lng + col0 + HALF + 4);
        bb[0] = *(const f32x4*)(lnb + col0); bb[1] = *(const f32x4*)(lnb + col0 + 4); bb[2] = *(const f32x4*)(lnb + col0 + HALF); bb[3] = *(const f32x4*)(lnb + col0 + HALF + 4);
        exchange(288, u.pm * BM, xr0, u.pn, cnt + 64 * u.pm, 64u, lds, wid, lane);
#pragma unroll
        for (int ai = 0; ai < 2; ++ai)
#pragma unroll
            for (int m = 0; m < 4; ++m) { const int rl = ai * HALF + wr * 64 + m * 16 + fr;
                xrow(acc[ai][0][m][0], acc[ai][0][m][1], acc[ai][1][m][0], acc[ai][1][m][1], u.pm * BM + rl, col0, S[rl], gg, bb); }
        xrow(accx[0][0], accx[0][1], accx[1][0], accx[1][1], xr0 + wr * 16 + fr, col0, S[xl], gg, bb);
    }
    __device__ __forceinline__ void operator()(const f32x4 (&)[2][2][4][2], const Unit&, int, int, int, int) const {}
    __device__ __forceinline__ void grp(f32x4, f32x4, f32x4, f32x4, const Unit&, int, int, int) const {}
};

template <class Epi, class Sched, bool ALIGN_EPI = false, bool SP2 = false, int XMODE = 0  >
__device__ __forceinline__ void gemm_phase(PG8_LAS unsigned char* lds, const Gemm g, const Sched& S, const Epi& E, const int tid) {
    constexpr bool XROWS = XMODE != 0;
    static_assert(!XROWS || SP2, "XROWS is written for the two-super-phase loop");
    const int wid = __builtin_amdgcn_readfirstlane(tid >> 6), lane = tid & 63, wr = wid >> 2, wc = wid & 3, fr = lane & 15, fq = lane >> 4;
    const int K = g.K, nt = K / BK;
    unsigned voffA[2], voffB[2];
#pragma unroll
    for (int i = 0; i < 2; ++i) { int R, C; stage_rc(tid * 16 + i * 8192, R, C); const int Rb = Epi::PERM ? ((R & ~31) + perm32(R & 31)) : R;
        voffA[i] = (unsigned)(R * g.lda + C) * 2u; voffB[i] = (unsigned)(Rb * g.ldb + C) * 2u; }
    const __amdgpu_buffer_rsrc_t rsA = __builtin_amdgcn_make_buffer_rsrc((void*)g.A, 0, 0x7fffffff, 0x00020000), rsB = __builtin_amdgcn_make_buffer_rsrc((void*)g.Bt, 0, 0x7fffffff, 0x00020000);
    const unsigned ksa = (unsigned)g.ksa, ksb = (unsigned)g.ksb;
    const __amdgpu_buffer_rsrc_t rsA0 = __builtin_amdgcn_make_buffer_rsrc((void*)g.A, 0, 0, 0x00020000), rsB0 = __builtin_amdgcn_make_buffer_rsrc((void*)g.Bt, 0, 0, 0x00020000);
    const unsigned hstepA = (unsigned)HALF * g.lda * 2, hstepB = (unsigned)HALF * g.ldb * 2;
    const unsigned tstepA = 2 * hstepA, tstepB = 2 * hstepB;
    const unsigned ldsw = (unsigned)wid * 1024u;
    const int aoff = lds_byte(wr * 64 + fr, fq * 8), boff = lds_byte(wc * 32 + fr, fq * 8);
    const unsigned xadj = 0u;
    const int xoff = lds_byte(wr * 16 + fr, fq * 8);
    int xo = STAGE_BYTES + xoff, xst = STAGE_BYTES + 8192;
    constexpr bool BK32 = SP2 && (XMODE == 0) && (PG8_BK32 != 0);
    unsigned voffA1, voffB1, wAo, wBo; const unsigned ldsw2 = (unsigned)wid * 2048u;
    const unsigned khA = (g.lda == 32) ? ksa / 2u : 64u, khB = (g.ldb == 32) ? ksb / 2u : 64u;
    const unsigned xwo = (unsigned)((((wid & 3) >> 1) * 16) * g.lda) * 2u + (unsigned)(wid & 1) * khA + ((wid >= 4) ? ksa : 0u);
    { const int sb = lane * 16, swz = sb ^ (((sb >> 9) & 1) << 5), r = swz >> 6, cb = swz & 63;
      voffA1 = (unsigned)(r * g.lda) * 2u + (unsigned)cb; voffB1 = (unsigned)((Epi::PERM ? (8 * (r >> 2) + (r & 3)) : r) * g.ldb) * 2u + (unsigned)cb;
      wAo = (unsigned)(wid * 16 * g.lda) * 2u; wBo = (unsigned)((Epi::PERM ? (32 * (wid >> 1) + 4 * (wid & 1)) : wid * 16) * g.ldb) * 2u; }
#define Q_ST1(rs, bufoff, soff, voff) __builtin_amdgcn_raw_ptr_buffer_load_lds(rs, (PG8_LAS unsigned*)(lds + (bufoff) + ldsw2), 16, voff, soff, 0, 0)
#define Q_STAGE(b, kh, ta, tb, RSA, RSB) do { Q_ST1(RSA, PG8_SA(b, 0) + (kh) * 1024, (ta) + wAo + (kh) * khA, voffA1); Q_ST1(RSA, PG8_SA(b, 1) + (kh) * 1024, (ta) + hstepA + wAo + (kh) * khA, voffA1); \
        Q_ST1(RSB, PG8_SB(b, 0) + (kh) * 1024, (tb) + wBo + (kh) * khB, voffB1); Q_ST1(RSB, PG8_SB(b, 1) + (kh) * 1024, (tb) + hstepB + wBo + (kh) * khB, voffB1); } while (0)
#define Q_LD(b, kh) do { _Pragma("unroll") for (int ai = 0; ai < 2; ++ai) _Pragma("unroll") for (int m = 0; m < 4; ++m) At[m][ai] = *(const PG8_LAS bf16x8*)(lds + PG8_SA(b, ai) + aoff + m * 2048 + (kh) * 1024); \
        _Pragma("unroll") for (int bj = 0; bj < 2; ++bj) _Pragma("unroll") for (int n = 0; n < 2; ++n) B0[bj][n] = *(const PG8_LAS bf16x8*)(lds + PG8_SB(b, bj) + boff + n * 2048 + (kh) * 1024); } while (0)
#define Q_MMA() do { __builtin_amdgcn_s_setprio(1); _Pragma("unroll") for (int ai = 0; ai < 2; ++ai) _Pragma("unroll") for (int bj = 0; bj < 2; ++bj) _Pragma("unroll") for (int m = 0; m < 4; ++m) _Pragma("unroll") for (int n = 0; n < 2; ++n) \
        acc[ai][bj][m][n] = __builtin_amdgcn_mfma_f32_16x16x32_bf16(B0[bj][n], At[m][ai], acc[ai][bj][m][n], 0, 0, 0); __builtin_amdgcn_s_setprio(0); } while (0)
#define PG8_XS(b) (STAGE_BYTES + (b) * 8192)
#define PG8_XSTAGE(b, soff) do { if constexpr (XROWS) __builtin_amdgcn_raw_ptr_buffer_load_lds(rsA, (PG8_LAS unsigned*)(lds + PG8_XS(b) + ldsw), 16, voffA1, (soff) + xwo, 0, 0); } while (0)
#define PG8_XSTAGEQ(soff) do { if constexpr (XROWS) __builtin_amdgcn_raw_ptr_buffer_load_lds(rsA2, (PG8_LAS unsigned*)(lds + xst + ldsw), 16, voffA1, (soff) + xwo, 0, 0); } while (0)
#define PG8_LDX(b) do { if constexpr (XROWS) if (XMODE == 1 || hx) { _Pragma("unroll") for (int k = 0; k < 2; ++k) Xf[k] = *(const PG8_LAS bf16x8*)(lds + xo + (b) * 4096 + k * 1024); } } while (0)
#define PG8_MMAX() do { if constexpr (XROWS) { if (XMODE == 1 || hx) { __builtin_amdgcn_s_setprio(1); _Pragma("unroll") for (int k = 0; k < 2; ++k) _Pragma("unroll") for (int n = 0; n < 2; ++n) { \
        accx[0][n] = __builtin_amdgcn_mfma_f32_16x16x32_bf16(B0[n][k], Xf[k], accx[0][n], 0, 0, 0); accx[1][n] = __builtin_amdgcn_mfma_f32_16x16x32_bf16(B1[n][k], Xf[k], accx[1][n], 0, 0, 0); } \
        __builtin_amdgcn_s_setprio(0); } __builtin_amdgcn_sched_barrier(0); } } while (0)
#define PG8_XOFF(u) ((unsigned)(MP + 32 * (u).pm) * (unsigned)(g.lda * 2) + (unsigned)((u).pn / g.grp_tiles) * (unsigned)(g.grp_koff * 2))
#define PG8_SA(b, h) (((b) * 2 + (h)) * HTB)
#define PG8_SB(b, h) ((4 + (b) * 2 + (h)) * HTB)
#define PG8_STAGEX(rs, bufoff, soff, isb) do { Q_ST1(rs, (bufoff), (soff) + ((isb) ? wBo : wAo), ((isb) ? voffB1 : voffA1)); Q_ST1(rs, (bufoff) + 1024, (soff) + ((isb) ? wBo : wAo) + ((isb) ? khB : khA), ((isb) ? voffB1 : voffA1)); } while (0)
#define PG8_STAGE(bufoff, soff, voff, isb) PG8_STAGEX(((isb) ? rsB : rsA), bufoff, soff, isb)
#define PG8_STAGE2(bufoff, soff, voff, isb) PG8_STAGEX(((isb) ? rsB2 : rsA2), bufoff, soff, isb)
#define PG8_LDA(dst, b, h) do { _Pragma("unroll") for (int m = 0; m < 4; ++m) _Pragma("unroll") for (int k = 0; k < 2; ++k) dst[m][k] = *(const PG8_LAS bf16x8*)(lds + PG8_SA(b, h) + aoff + m * 2048 + k * 1024); } while (0)
#define PG8_LDB(dst, b, h) do { _Pragma("unroll") for (int n = 0; n < 2; ++n) _Pragma("unroll") for (int k = 0; k < 2; ++k) dst[n][k] = *(const PG8_LAS bf16x8*)(lds + PG8_SB(b, h) + boff + n * 2048 + k * 1024); } while (0)
#define PG8_MMA(ai, bj, At, Bt) do { __builtin_amdgcn_s_setprio(1); _Pragma("unroll") for (int m = 0; m < 4; ++m) _Pragma("unroll") for (int n = 0; n < 2; ++n) _Pragma("unroll") for (int k = 0; k < 2; ++k) \
        acc[ai][bj][m][n] = __builtin_amdgcn_mfma_f32_16x16x32_bf16(Bt[n][k], At[m][k], acc[ai][bj][m][n], 0, 0, 0); __builtin_amdgcn_s_setprio(0); } while (0)
#define PG8_WAIT_V(n) asm volatile("s_waitcnt vmcnt(" #n ")" ::: "memory")
#define PG8_WAIT_L(n) asm volatile("s_waitcnt lgkmcnt(" #n ")" ::: "memory")
#define PG8_BAR __builtin_amdgcn_s_barrier()
#define PG8_SCHED __builtin_amdgcn_sched_barrier(0)
#define PG8_AOFF(u) ((unsigned)(u).pm * tstepA + (unsigned)((u).pn / g.grp_tiles) * (unsigned)(g.grp_koff * 2))
    Unit cur, nxt; int ui = 0;
    if (!S.next(0, cur)) return;
    f32x4 acc[2][2][4][2];
    bf16x8 At[4][2], B0[2][2], B1[2][2]; bf16x8 Xf[2]; f32x4 accx[2][2];
    if constexpr (!Epi::INIT_ACC) {
#pragma unroll
    for (int a = 0; a < 2; ++a)
#pragma unroll
        for (int b = 0; b < 2; ++b)
#pragma unroll
            for (int m = 0; m < 4; ++m)
#pragma unroll
                for (int n = 0; n < 2; ++n) acc[a][b][m][n] = (f32x4){0.f, 0.f, 0.f, 0.f};
#pragma unroll
    for (int b = 0; b < 2; ++b)
#pragma unroll
        for (int n = 0; n < 2; ++n) accx[b][n] = (f32x4){0.f, 0.f, 0.f, 0.f};
    }
    bool hx = false; if constexpr (XMODE == 2) hx = S.hasx(cur);
    unsigned cA = PG8_AOFF(cur), cB = (unsigned)cur.pn * tstepB, cX = (XMODE == 1 || hx) ? PG8_XOFF(cur) : cA + xadj;
    S.a_ready(cur);
    u32x2 irs[9][4];
    if constexpr (Epi::INIT_ACC) E.init_load(irs, cur, wr, wc, fr, fq);
    if constexpr (BK32) {
        Q_STAGE(0, 0, cA, cB, rsA, rsB); Q_STAGE(0, 1, cA, cB, rsA, rsB); Q_STAGE(1, 0, cA + ksa, cB + ksb, rsA, rsB);
        if (wr == 1) PG8_BAR;
        PG8_WAIT_V(8);
        PG8_BAR; PG8_BAR;
    } else if constexpr (SP2) {
        PG8_STAGE(PG8_SB(0, 0), cB, voffB, 1); PG8_STAGE(PG8_SB(0, 1), cB + hstepB, voffB, 1); PG8_STAGE(PG8_SA(0, 0), cA, voffA, 0); PG8_STAGE(PG8_SA(0, 1), cA + hstepA, voffA, 0); PG8_XSTAGE(0, cX);
        if (wr == 1) PG8_BAR;
        if constexpr (XROWS) PG8_WAIT_V(3); else PG8_WAIT_V(2);
        PG8_BAR;
        PG8_STAGE(PG8_SB(1, 0), cB + ksb, voffB, 1); PG8_STAGE(PG8_SA(1, 0), cA + ksa, voffA, 0); PG8_STAGE(PG8_SB(1, 1), cB + hstepB + ksb, voffB, 1);
        PG8_WAIT_V(6); PG8_BAR;
        if (PG8_ASYM && wr == 1) { PG8_STAGE(PG8_SA(1, 1), cA + hstepA + ksa, voffA, 0); PG8_XSTAGE(1, cX + ksa); }
    } else {
        PG8_STAGE(PG8_SB(0, 0), cB, voffB, 1); PG8_STAGE(PG8_SA(0, 0), cA, voffA, 0); PG8_STAGE(PG8_SB(0, 1), cB + hstepB, voffB, 1); PG8_STAGE(PG8_SA(0, 1), cA + hstepA, voffA, 0);
        if (wr == 1) PG8_BAR;
        PG8_WAIT_V(4); PG8_BAR;
        PG8_STAGE(PG8_SB(1, 0), cB + ksb, voffB, 1); PG8_STAGE(PG8_SA(1, 0), cA + ksa, voffA, 0); PG8_STAGE(PG8_SB(1, 1), cB + hstepB + ksb, voffB, 1);
        PG8_WAIT_V(6); PG8_BAR;
    }
    if constexpr (Epi::INIT_ACC) E.init_cvt(acc, accx, irs);
    for (;;) {
        const bool has_next = S.next(ui + 1, nxt);
        asm volatile("" : "+s"(cA), "+s"(cB), "+s"(cX));
        unsigned nA = has_next ? PG8_AOFF(nxt) : cA, nB = has_next ? (unsigned)nxt.pn * tstepB : cB; bool nhx = false; if constexpr (XMODE == 2) nhx = has_next && S.hasx(nxt);
        unsigned nX = has_next ? ((XMODE == 1 || nhx) ? PG8_XOFF(nxt) : nA + xadj) : cX; asm volatile("" : "+s"(nA), "+s"(nB), "+s"(nX));
        for (int t = 0; t < nt; t += 2) {
            const bool last = (t == nt - 2);
            const unsigned a1 = cA + (unsigned)(t + 1) * ksa;
            const unsigned a2 = last ? nA : cA + (unsigned)(t + 2) * ksa, b2 = last ? nB : cB + (unsigned)(t + 2) * ksb;
            const unsigned a3 = a2 + ksa, b3 = b2 + ksb;
            if (last && has_next) S.a_ready(nxt);
            const bool dry = last && !has_next;
            const __amdgpu_buffer_rsrc_t rsA2 = dry ? rsA0 : rsA, rsB2 = dry ? rsB0 : rsB;
            if constexpr (BK32) {
            const unsigned b1t = cB + (unsigned)(t + 1) * ksb;
            Q_LD(0, 0); PG8_SCHED; Q_STAGE(1, 1, a1, b1t, rsA, rsB);  PG8_WAIT_V(8); PG8_WAIT_L(0); PG8_BAR; Q_MMA(); PG8_SCHED; PG8_BAR; PG8_SCHED;
            Q_LD(0, 1); PG8_SCHED; Q_STAGE(0, 0, a2, b2, rsA2, rsB2); PG8_WAIT_V(8); PG8_WAIT_L(0); PG8_BAR; Q_MMA(); PG8_SCHED; PG8_BAR; PG8_SCHED;
            Q_LD(1, 0); PG8_SCHED; Q_STAGE(0, 1, a2, b2, rsA2, rsB2); PG8_WAIT_V(8); PG8_WAIT_L(0); PG8_BAR; Q_MMA(); PG8_SCHED; PG8_BAR; PG8_SCHED;
            Q_LD(1, 1); PG8_SCHED; Q_STAGE(1, 0, a3, b3, rsA2, rsB2); PG8_WAIT_V(8); PG8_WAIT_L(0); PG8_BAR; Q_MMA(); PG8_SCHED; PG8_BAR; PG8_SCHED;
            } else if constexpr (SP2) {
#define PG8_WAIT_SPA() PG8_WAIT_V(8)
#define PG8_WAIT_SPB() do { if constexpr (XROWS) PG8_WAIT_V(9); else PG8_WAIT_V(8); } while (0)
            const unsigned x1 = cX + (unsigned)(t + 1) * ksa, x2 = last ? nX : cX + (unsigned)(t + 2) * ksa, x3 = x2 + ksa;
            const bool WL = PG8_ASYM && (wr == 0), IE = PG8_ASYM && (wr == 1);
            PG8_LDB(B0, 0, 0); PG8_LDB(B1, 0, 1); PG8_SCHED; PG8_LDA(At, 0, 0); if (!IE) { PG8_STAGE(PG8_SA(1, 1), a1 + hstepA, voffA, 0); }
            if (!WL) PG8_WAIT_SPA(); PG8_WAIT_L(0); PG8_BAR;
            if (IE) { PG8_STAGE2(PG8_SB(0, 0), b2, voffB, 1); PG8_STAGE2(PG8_SB(0, 1), b2 + hstepB, voffB, 1); PG8_STAGE2(PG8_SA(0, 0), a2, voffA, 0); }
            PG8_MMA(0, 0, At, B0); PG8_MMA(0, 1, At, B1); PG8_SCHED; if (WL) PG8_WAIT_SPA(); PG8_BAR; PG8_SCHED;
            PG8_LDA(At, 0, 1); PG8_LDX(0); if (!IE) { PG8_STAGE2(PG8_SB(0, 0), b2, voffB, 1); PG8_STAGE2(PG8_SB(0, 1), b2 + hstepB, voffB, 1); PG8_STAGE2(PG8_SA(0, 0), a2, voffA, 0); }
            if (!WL) PG8_WAIT_SPA(); PG8_WAIT_L(0); PG8_BAR;
            if (IE) { PG8_STAGE2(PG8_SA(0, 1), a2 + hstepA, voffA, 0); PG8_XSTAGE(0, x2); }
            PG8_MMA(1, 0, At, B0); PG8_MMA(1, 1, At, B1); PG8_MMAX(); PG8_SCHED; if (WL) PG8_WAIT_SPA(); PG8_BAR; PG8_SCHED;
            PG8_LDB(B0, 1, 0); PG8_LDB(B1, 1, 1); PG8_SCHED; PG8_LDA(At, 1, 0); if (!IE) { PG8_STAGE2(PG8_SA(0, 1), a2 + hstepA, voffA, 0); PG8_XSTAGEQ(x2); }
            if (!WL) PG8_WAIT_SPB(); PG8_WAIT_L(0); PG8_BAR;
            if (IE) { PG8_STAGE2(PG8_SB(1, 0), b3, voffB, 1); PG8_STAGE2(PG8_SB(1, 1), b3 + hstepB, voffB, 1); PG8_STAGE2(PG8_SA(1, 0), a3, voffA, 0); }
            PG8_MMA(0, 0, At, B0); PG8_MMA(0, 1, At, B1); PG8_SCHED; if (WL) PG8_WAIT_SPB(); PG8_BAR; PG8_SCHED;
            PG8_LDA(At, 1, 1); PG8_LDX(1); if (!IE) { PG8_STAGE2(PG8_SB(1, 0), b3, voffB, 1); PG8_STAGE2(PG8_SB(1, 1), b3 + hstepB, voffB, 1); PG8_STAGE2(PG8_SA(1, 0), a3, voffA, 0); }
            if (!WL) PG8_WAIT_SPB(); PG8_WAIT_L(0); PG8_BAR;
            if (IE) { PG8_STAGE2(PG8_SA(1, 1), a3 + hstepA, voffA, 0); PG8_XSTAGE(1, x3); }
            PG8_MMA(1, 0, At, B0); PG8_MMA(1, 1, At, B1); PG8_MMAX(); PG8_SCHED; if (WL) PG8_WAIT_SPB(); PG8_BAR; PG8_SCHED;
            xo ^= 8192; xst ^= 8192;
#undef PG8_WAIT_SPA
#undef PG8_WAIT_SPB
            } else {
            PG8_LDB(B0, 0, 0); PG8_SCHED; PG8_LDA(At, 0, 0); PG8_STAGE(PG8_SA(1, 1), a1 + hstepA, voffA, 0);
            PG8_WAIT_L(8); PG8_BAR; PG8_WAIT_L(0); PG8_MMA(0, 0, At, B0); PG8_BAR; PG8_SCHED;
            PG8_LDB(B1, 0, 1); PG8_STAGE(PG8_SB(0, 0), b2, voffB, 1);
            PG8_BAR; PG8_WAIT_L(0); PG8_MMA(0, 1, At, B1); PG8_BAR;
            PG8_LDA(At, 0, 1); PG8_STAGE(PG8_SA(0, 0), a2, voffA, 0);
            PG8_BAR; PG8_WAIT_L(0); PG8_MMA(1, 0, At, B0); PG8_BAR; PG8_SCHED;
            PG8_STAGE(PG8_SB(0, 1), b2 + hstepB, voffB, 1);
            PG8_WAIT_V(6); PG8_BAR; PG8_MMA(1, 1, At, B1); PG8_BAR;
            PG8_LDB(B0, 1, 0); PG8_SCHED; PG8_LDA(At, 1, 0); PG8_STAGE(PG8_SA(0, 1), a2 + hstepA, voffA, 0);
            PG8_WAIT_L(8); PG8_BAR; PG8_WAIT_L(0); PG8_MMA(0, 0, At, B0); PG8_BAR; PG8_SCHED;
            PG8_LDB(B1, 1, 1); PG8_STAGE(PG8_SB(1, 0), b3, voffB, 1);
            PG8_BAR; PG8_WAIT_L(0); PG8_MMA(0, 1, At, B1); PG8_BAR;
            PG8_LDA(At, 1, 1); PG8_STAGE(PG8_SA(1, 0), a3, voffA, 0);
            PG8_BAR; PG8_WAIT_L(0); PG8_MMA(1, 0, At, B0); PG8_BAR; PG8_SCHED;
            PG8_STAGE(PG8_SB(1, 1), b3 + hstepB, voffB, 1);
            PG8_WAIT_V(6); PG8_BAR; PG8_MMA(1, 1, At, B1); PG8_BAR;
            }
        }
        if constexpr (ALIGN_EPI) { if (wr == 0) PG8_BAR; }
        if constexpr (!Epi::AFTER_DRAIN) { int el = lane; asm volatile("" : "+v"(el)); const int efr = el & 15, efq = el >> 4;
            E(acc, cur, wr, wc, efr, efq);
            if constexpr (XROWS) if (XMODE == 1 || hx) E.grp(accx[0][0], accx[0][1], accx[1][0], accx[1][1], cur, MP + 32 * cur.pm + wr * 16 + efr, wc, efq); }
        if (!has_next) break;
#pragma unroll
        for (int a = 0; a < 2; ++a)
#pragma unroll
            for (int b = 0; b < 2; ++b)
#pragma unroll
                for (int m = 0; m < 4; ++m)
#pragma unroll
                    for (int n = 0; n < 2; ++n) acc[a][b][m][n] = (f32x4){0.f, 0.f, 0.f, 0.f};
        if constexpr (XROWS) {
#pragma unroll
            for (int b = 0; b < 2; ++b)
#pragma unroll
                for (int n = 0; n < 2; ++n) accx[b][n] = (f32x4){0.f, 0.f, 0.f, 0.f}; }
        cur = nxt; cA = nA; cB = nB; cX = nX; hx = nhx; ++ui;
        if constexpr (ALIGN_EPI) { if (wr == 1) PG8_BAR; }
    }
    PG8_WAIT_V(0);
    if constexpr (!ALIGN_EPI) { if (wr == 0) PG8_BAR; }
    PG8_BAR;
    if constexpr (Epi::AFTER_DRAIN) E.fused_tile(acc, accx, cur, wr, wc, fr, fq, lds, wid, lane);
#undef PG8_SA
#undef PG8_SB
#undef PG8_LDA
#undef PG8_LDB
#undef PG8_MMA
#undef PG8_XS
#undef PG8_XSTAGE
#undef PG8_LDX
#undef PG8_MMAX
#undef PG8_XOFF
}

template <class Epi, class Sched>
__device__ __forceinline__ void gemm_sub_phase(PG8_LAS unsigned char* lds, const Gemm g, const Sched& S, const Epi& E, const int tid) {
    const int wid = __builtin_amdgcn_readfirstlane(tid >> 6), lane = tid & 63, wm = wid >> 2, wc = wid & 3, fr = lane & 15, fq = lane >> 4;
    const int nt = g.K / BK;
    unsigned voffA, voffB[2];
    { int R, C; stage_rc((tid & 255) * 16, R, C); voffA = (unsigned)(R * g.lda + C) * 2u; }
#pragma unroll
    for (int i = 0; i < 2; ++i) { int R, C; stage_rc(tid * 16 + i * 8192, R, C); const int Rb = Epi::PERM ? ((R & ~31) + perm32(R & 31)) : R; voffB[i] = (unsigned)(Rb * g.ldb + C) * 2u; }
    const size_t ksa = (size_t)g.ksa, ksb = (size_t)g.ksb, hstepB = (size_t)HALF * g.ldb * 2;
    const unsigned ldsw = (unsigned)wid * 1024u;
    const int aoff = lds_byte(wm * 16 + fr, fq * 8), boff = 4096 + lds_byte(wc * 32 + fr, fq * 8);
    constexpr int SS = 36864;
    const bool lda_wave = wid < 4;
#define PG8_SUBSTAGE(so, kt) do { const char* _a = gA + (size_t)(kt) * ksa; const char* _b = gB + (size_t)(kt) * ksb; \
        if (lda_wave) __builtin_amdgcn_global_load_lds((const unsigned*)(_a + voffA), (PG8_LAS unsigned*)(lds + (so) + ldsw), 16, 0, 0); \
        _Pragma("unroll") for (int _h = 0; _h < 2; ++_h) _Pragma("unroll") for (int _i = 0; _i < 2; ++_i) \
            __builtin_amdgcn_global_load_lds((const unsigned*)(_b + _h * hstepB + voffB[_i]), (PG8_LAS unsigned*)(lds + (so) + 4096 + _h * 16384 + _i * 8192 + ldsw), 16, 0, 0); } while (0)
    Unit u; int sub;
    for (int i = 0; S.next_sub(i, u, sub); ++i) {
        const char* gA = (const char*)g.A + ((size_t)u.pm * BM + sub * 32) * g.lda * 2 + (size_t)(u.pn / g.grp_tiles) * (size_t)g.grp_koff * 2;
        const char* gB = (const char*)g.Bt + (size_t)u.pn * BM * g.ldb * 2;
        f32x4 acc[2][2];
#pragma unroll
        for (int b = 0; b < 2; ++b)
#pragma unroll
            for (int n = 0; n < 2; ++n) acc[b][n] = (f32x4){0.f, 0.f, 0.f, 0.f};
        int s0 = 0, s1 = SS, s2 = 2 * SS, s3 = 3 * SS;
        PG8_SUBSTAGE(s0, 0); PG8_SUBSTAGE(s1, 1); PG8_SUBSTAGE(s2, (nt > 2 ? 2 : nt - 1));
        for (int t = 0; t < nt; ++t) {
            if (lda_wave) PG8_WAIT_V(10); else PG8_WAIT_V(8);
            PG8_BAR;
            const int tn = (t + 3 < nt) ? t + 3 : nt - 1;
            PG8_SUBSTAGE(s3, tn);
            bf16x8 Af[2], Bf[2][2][2];
#pragma unroll
            for (int k = 0; k < 2; ++k) Af[k] = *(const PG8_LAS bf16x8*)(lds + s0 + aoff + k * 1024);
#pragma unroll
            for (int b = 0; b < 2; ++b)
#pragma unroll
                for (int n = 0; n < 2; ++n)
#pragma unroll
                    for (int k = 0; k < 2; ++k) Bf[b][n][k] = *(const PG8_LAS bf16x8*)(lds + s0 + boff + b * 16384 + n * 2048 + k * 1024);
#pragma unroll
            for (int k = 0; k < 2; ++k)
#pragma unroll
                for (int b = 0; b < 2; ++b)
#pragma unroll
                    for (int n = 0; n < 2; ++n) acc[b][n] = __builtin_amdgcn_mfma_f32_16x16x32_bf16(Bf[b][n][k], Af[k], acc[b][n], 0, 0, 0);
            const int st = s0; s0 = s1; s1 = s2; s2 = s3; s3 = st;
        }
        PG8_WAIT_V(0); PG8_BAR;
        E.grp(acc[0][0], acc[0][1], acc[1][0], acc[1][1], u, u.pm * BM + sub * 32 + wm * 16 + fr, wc, fq);
    }
#undef PG8_SUBSTAGE
#undef PG8_AOFF
#undef PG8_STAGE
#undef PG8_WAIT_V
#undef PG8_WAIT_L
#undef PG8_BAR
#undef PG8_SCHED
}
}

constexpr size_t MiB = 1u << 20;
constexpr size_t WS_CTL = 0, CTL_ZERO_BYTES = 2 * MiB;
constexpr size_t SZ_WGU = (size_t)2 * DFF * LDK * 2, SZ_WD = (size_t)DM * DFF * 2;
constexpr size_t WS_WGU = 2 * MiB, WS_WD = WS_WGU + 8 * SZ_WGU;
constexpr size_t WS_AIN = WS_WD + 8 * SZ_WD, WS_AOUT = WS_AIN + 2 * (size_t)4096 * LDK * 2, WS_BGRP = WS_AOUT + 2 * (size_t)DM * LDK * 2,
                 WS_CIN = WS_BGRP + (size_t)DM * 512 * 2, WS_COUT = WS_CIN + (size_t)6144 * LDK * 2, WS_WEND = WS_COUT + (size_t)DM * LDK * 2;
constexpr size_t WS_XB = (WS_WEND + MiB - 1) / MiB * MiB;
constexpr size_t WS_ACT = WS_XB + (size_t)M * LDK * 2;
constexpr size_t WS_UV = WS_ACT + (size_t)M * DFF * 2;
constexpr size_t WS_T1 = WS_UV + (size_t)M * 4096 * 2;
constexpr size_t WS_T2 = WS_T1 + (size_t)M * LDK * 2;
constexpr size_t WS_PART = WS_T2 + (size_t)M * LDK * 2;
constexpr size_t WS_SLOT_OLD = WS_PART + (size_t)M * DM * 4, WS_SLOT = 1 * MiB;
constexpr size_t WS_VST = WS_SLOT_OLD + (size_t)M * 8 * 8;
constexpr size_t WS_END = WS_VST + (size_t)2 * M * 32 * 2 * 4;
constexpr int CW_BAR = 4096, CW_TMO = 0, CW_LN = 16384, LN_BANK = 128 * 64, CW_FLAG = 65536;

constexpr int RING_OFF = 0, RING_BYTES = 147456;
constexpr int LDSCTL_OFF = RING_BYTES, MISC_OFF = LDSCTL_OFF + 320;
constexpr int LDS_BYTES = 151552;
constexpr int NWAVES = 8;

#define GAS __attribute__((address_space(1)))
#define LAS __attribute__((address_space(3)))
typedef unsigned short bf16;
typedef unsigned v4u __attribute__((ext_vector_type(4)));
typedef unsigned v2u __attribute__((ext_vector_type(2)));
typedef float f32x4 __attribute__((ext_vector_type(4)));
typedef short bf16x8 __attribute__((ext_vector_type(8)));
typedef short s16x4 __attribute__((ext_vector_type(4)));
typedef float f32x2v __attribute__((ext_vector_type(2)));
#define LDS_WAIT() asm volatile("s_waitcnt lgkmcnt(0)" ::: "memory")
#define VM_WAIT() asm volatile("s_waitcnt vmcnt(0)" ::: "memory")
__device__ __forceinline__ int opaque_tid(int wave_id) { int l; asm volatile("v_mbcnt_lo_u32_b32 %0, -1, 0\n\tv_mbcnt_hi_u32_b32 %0, -1, %0" : "=v"(l)); return wave_id * 64 + l; }
__device__ __forceinline__ unsigned pk2(float lo, float hi) { return pg8::cvt_pk_bf16(lo, hi); }
__device__ __forceinline__ float bflo(unsigned u) { return __builtin_bit_cast(float, u << 16); }
__device__ __forceinline__ float bfhi(unsigned u) { return __builtin_bit_cast(float, u & 0xffff0000u); }

#define XB_TMO      128
#define XB_XCNT(j)  (256  + 64 * (j))
#define XB_XSUB(j)  (1280 + 64 * (j))
#define XB_XGEN(j)  (2304 + 64 * (j))
#define XB_TOP      3328
#define XB_TOPGEN   3392
#define XCD_BAR_WORDS 3456
#define XB_SPIN_CAP (1u << 18)
__device__ __forceinline__ unsigned xb_ld(unsigned* p)              { return __hip_atomic_load((GAS unsigned*)p, __ATOMIC_RELAXED, __HIP_MEMORY_SCOPE_AGENT); }
__device__ __forceinline__ unsigned xb_add(unsigned* p, unsigned v) { return __hip_atomic_fetch_add((GAS unsigned*)p, v, __ATOMIC_RELAXED, __HIP_MEMORY_SCOPE_AGENT); }
__device__ __forceinline__ unsigned xb_xcc_id() { return (unsigned)__builtin_amdgcn_s_getreg((3 << 11) | 20) & 0xFu; }
#define XB_SPIN(cond, bar) do { unsigned _sp = 0; while (cond) { __builtin_amdgcn_s_sleep(1); \
    if ((++_sp & 255u) == 0u) { if (xb_ld(&(bar)[XB_TMO])) break; if (_sp > XB_SPIN_CAP) { xb_add(&(bar)[XB_TMO], 1u); break; } } } } while (0)
struct XcdBarrier { unsigned* bar; unsigned x; volatile LAS unsigned* st; };
__device__ __forceinline__ XcdBarrier xcd_barrier_post(unsigned* bar, volatile LAS unsigned* st, int tid) {
    XcdBarrier b; b.bar = bar; b.x = xb_xcc_id(); b.st = st;
    if (tid == 0) (void)xb_add(&bar[XB_XCNT(b.x)], 1u);
    return b;
}
__device__ __forceinline__ void xcd_barrier_complete(unsigned* bar, unsigned x, unsigned& nloc, unsigned& nx) {
    const unsigned G = gridDim.x * gridDim.y * gridDim.z;
    unsigned sum, cnt, mine, sp = 0u;
    for (;;) {
        sum = 0u; cnt = 0u; mine = 0u;
#pragma unroll
        for (unsigned j = 0; j < 16; ++j) { const unsigned c = xb_ld(&bar[XB_XCNT(j)]); sum += c; cnt += (c > 0u) ? 1u : 0u; mine = (j == x) ? c : mine; }
        if (sum == G) break;
        __builtin_amdgcn_s_sleep(1);
        if ((++sp & 255u) == 0u) { if (xb_ld(&bar[XB_TMO])) break; if (sp > XB_SPIN_CAP) { xb_add(&bar[XB_TMO], 1u); break; } }
    }
    nloc = mine > 0u ? mine : 1u; nx = cnt > 0u ? cnt : 1u;
}
__device__ __forceinline__ void xcd_barrier(const XcdBarrier& b, int tid) {
    asm volatile("s_waitcnt vmcnt(0)" ::: "memory");
    __syncthreads();
    if (tid == 0) {
        unsigned* bar = b.bar; asm volatile("" : "+s"(bar)); bar = (unsigned*)(GAS unsigned*)bar;
        __builtin_amdgcn_s_waitcnt(0);
        unsigned nloc = b.st[0], nx = b.st[1];
        if (nloc == 0u) { xcd_barrier_complete(bar, b.x, nloc, nx); b.st[0] = nloc; b.st[1] = nx; }
        const unsigned old = xb_add(&bar[XB_XSUB(b.x)], 1u);
        const unsigned gen = old / nloc;
        if (old + 1u == (gen + 1u) * nloc) {
            __builtin_amdgcn_fence(__ATOMIC_RELEASE, "agent");
            asm volatile("s_waitcnt vmcnt(0)" ::: "memory");
            const unsigned og = xb_add(&bar[XB_TOP], 1u);
            const unsigned tg = og / nx;
            if (og + 1u == (tg + 1u) * nx) xb_add(&bar[XB_TOPGEN], 1u);
            else XB_SPIN(xb_ld(&bar[XB_TOPGEN]) == tg, bar);
            __builtin_amdgcn_fence(__ATOMIC_ACQUIRE, "agent");
            xb_add(&bar[XB_XGEN(b.x)], 1u);
            asm volatile("s_waitcnt vmcnt(0)" ::: "memory");
        } else {
            XB_SPIN(xb_ld(&bar[XB_XGEN(b.x)]) == gen, bar);
            __builtin_amdgcn_fence(__ATOMIC_ACQUIRE, "agent");
            asm volatile("s_waitcnt vmcnt(0)" ::: "memory");
        }
    }
    __syncthreads();
}

__device__ __forceinline__ float wave_sum(float v, int lane) {
#pragma unroll
    for (int o = 1; o < 64; o <<= 1) v += __builtin_bit_cast(float, __builtin_amdgcn_ds_bpermute((lane ^ o) << 2, __builtin_bit_cast(int, v)));
    return v;
}
__device__ __forceinline__ void p0_transpose_item(const float* W, int N, bf16* WT, int ldk, int k0, int n0, int drow0, LAS float* scr, int lane, int km_rows = 0  , int k32 = 0  , const float* colsc = nullptr  ) {
#pragma unroll 8
    for (int i = 0; i < 32; ++i) { const int kk = 2 * i + (lane >> 5); scr[kk * 33 + (lane & 31)] = __builtin_nontemporal_load(W + (size_t)(k0 + kk) * N + n0 + (lane & 31)); }
    LDS_WAIT(); asm volatile("" ::: "memory");
    const int c = lane & 7;
#pragma unroll
    for (int j = 0; j < 4; ++j) { const int n = (lane >> 3) + 8 * j; const LAS float* s = scr + (8 * c) * 33 + n;
        const float sc = colsc ? colsc[drow0 + n] : 1.0f;
        v4u o; o.x = pk2(s[0 * 33] * sc, s[1 * 33] * sc); o.y = pk2(s[2 * 33] * sc, s[3 * 33] * sc); o.z = pk2(s[4 * 33] * sc, s[5 * 33] * sc); o.w = pk2(s[6 * 33] * sc, s[7 * 33] * sc);
        if (k32) __builtin_nontemporal_store(o, (v4u*)(WT + ((size_t)((k0 >> 5) + (c >> 2)) * km_rows + drow0 + n) * 32 + 8 * (c & 3)));
        else if (km_rows) __builtin_nontemporal_store(o, (v4u*)(WT + ((size_t)(k0 >> 6) * km_rows + drow0 + n) * 64 + 8 * c)); else __builtin_nontemporal_store(o, (v4u*)(WT + (size_t)(drow0 + n) * ldk + k0 + 8 * c)); }
    LDS_WAIT(); asm volatile("" ::: "memory");
}

__device__ __forceinline__ size_t xb_idx(int m, int c) { return ((size_t)(c >> 5) * M + (size_t)m) * 32 + (size_t)(c & 31); }

struct Args { const float* in[25]; float* out; unsigned char* ws; int ph_lo, ph_hi; };

__global__ void __launch_bounds__(NWAVES * 64, 2) fwd_kernel(Args args) {
    extern __shared__ __attribute__((aligned(16))) unsigned char lds_raw[];
    LAS unsigned char* lds = (LAS unsigned char*)lds_raw;
    volatile LAS unsigned* MISC = (volatile LAS unsigned*)(lds + MISC_OFF);
    const int G = gridDim.x; const int bx = blockIdx.x;
    const int wave_id = __builtin_amdgcn_readfirstlane((int)threadIdx.x >> 6);
    const int vcu = (G % 8 == 0) ? (bx % 8) * (G / 8) + bx / 8 : bx;
    const int NGW = G * NWAVES;
#define PH_IDS() const int tid = opaque_tid(wave_id), lane = tid & 63, wave = __builtin_amdgcn_readfirstlane(tid >> 6), gw = vcu * NWAVES + wave; (void)lane; (void)gw
#define INP(i) ((const float*)(const GAS float*)ap->in[i])
#define PH_PTRS() const __attribute__((address_space(4))) Args* ap = (const __attribute__((address_space(4))) Args*)__builtin_amdgcn_kernarg_segment_ptr(); asm volatile("" : "+s"(ap)); \
    unsigned char* const ws = (unsigned char*)(GAS unsigned char*)ap->ws; unsigned* const ctl = (unsigned*)(ws + WS_CTL); float* const OUT = (float*)(GAS float*)ap->out; float* const X = OUT + OFF_Y; \
    bf16* const XB = (bf16*)(ws + WS_XB); bf16* const ACT = (bf16*)(ws + WS_ACT); bf16* const UV = (bf16*)(ws + WS_UV); bf16* const T1 = (bf16*)(ws + WS_T1); bf16* const T2 = (bf16*)(ws + WS_T2); \
    (void)ctl; (void)X; (void)XB; (void)ACT; (void)UV; (void)T1; (void)T2
    for (int u = threadIdx.x; u < (LDS_BYTES - LDSCTL_OFF) / 4; u += NWAVES * 64) ((LAS unsigned*)(lds + LDSCTL_OFF))[u] = 0u;
    __syncthreads();
    XcdBarrier bar; bar.bar = (unsigned*)(args.ws + WS_CTL) + CW_BAR; bar.x = 0; bar.st = nullptr;
    if (!MK_PER_PHASE) bar = xcd_barrier_post((unsigned*)(args.ws + WS_CTL) + CW_BAR, MISC + 8, (int)threadIdx.x);

    const int lo = args.ph_lo, hi = args.ph_hi;
    int ph = 0;
#define PH_ON() (lo <= ph && ph < hi)
#define PH_END() do { if (!MK_PER_PHASE && (ph + 1) < hi) for (int _r = 0; _r < REP_BAR; ++_r) xcd_barrier(bar, opaque_tid(wave_id)); ++ph; } while (0)

    if (PH_ON()) {
        PH_IDS(); PH_PTRS();
        LAS float* scr = (LAS float*)(lds + RING_OFF + wave * 16384);
        constexpr int I_GU = 32 * 344, I_D = 86 * 64, I_AIN = 32 * 128, I_SQ = 32 * 64, I_BG = 8 * 16, I_CIN = 32 * 192;
        constexpr int E0 = 4 * I_GU, E1 = E0 + 4 * I_D, E2 = E1 + 4 * I_GU, E3 = E2 + 4 * I_D, E4 = E3 + 2 * I_AIN, E5 = E4 + 2 * I_SQ, E6 = E5 + 4 * I_BG, E7 = E6 + I_CIN, E8 = E7 + I_SQ;
        for (int rep = 0; rep < REP_PRO; ++rep)
        for (int it = gw; it < E8; it += NGW) {
            if (it < E3) {
                const int which = (it >= E1) ? 1 : 0; int r = it - (which ? E1 : 0);
                if (r < E0) { const int mat = r / I_GU, q = r % I_GU, kb = q / 344, nb = q % 344, n0 = nb * 32;
                    const int nn = (n0 < DFF) ? n0 : n0 - DFF, drow0 = 256 * (nn >> 7) + (nn & 127) + ((n0 < DFF) ? 0 : 128);
                    p0_transpose_item(INP(which ? 6 : 4) + (size_t)mat * DM * 2 * DFF, 2 * DFF, (bf16*)(ws + WS_WGU + (size_t)(2 * mat + which) * SZ_WGU), LDK, kb * 64, n0, drow0, scr, lane, 2 * DFF, 1); }
                else { r -= E0; const int mat = r / I_D, q = r % I_D, kb = q / 64, nb = q % 64;
                    p0_transpose_item(INP(which ? 7 : 5) + (size_t)mat * DFF * DM, DM, (bf16*)(ws + WS_WD + (size_t)(2 * mat + which) * SZ_WD), DFF, kb * 64, nb * 32, nb * 32, scr, lane, DM); }
            } else if (it < E4) { const int r = it - E3, mat = r / I_AIN, q = r % I_AIN, kb = q / 128, nb = q % 128;
                p0_transpose_item(INP(14) + (size_t)mat * DM * 4096, 4096, (bf16*)(ws + WS_AIN) + (size_t)mat * 4096 * LDK, LDK, kb * 64, nb * 32, nb * 32, scr, lane);
            } else if (it < E5) { const int r = it - E4, mat = r / I_SQ, q = r % I_SQ, kb = q / 64, nb = q % 64;
                p0_transpose_item(INP(19) + (size_t)mat * DM * DM, DM, (bf16*)(ws + WS_AOUT) + (size_t)mat * DM * LDK, LDK, kb * 64, nb * 32, nb * 32, scr, lane);
            } else if (it < E6) { const int r = it - E5, mat = r / I_BG, q = r % I_BG, kb = q / 16, nb = q % 16;
                p0_transpose_item(INP(20) + (size_t)mat * 512 * 512, 512, (bf16*)(ws + WS_BGRP), 512, kb * 64, nb * 32, mat * 512 + nb * 32, scr, lane, 0, 0, INP(21));
            } else if (it < E7) { const int r = it - E6, kb = r / 192, nb = r % 192, n0 = nb * 32;
                int drow0; if (n0 < 2048) drow0 = n0; else { const int nn = (n0 < 4096) ? n0 - 2048 : n0 - 4096; drow0 = 2048 + 256 * (nn >> 7) + (nn & 127) + ((n0 < 4096) ? 0 : 128); }
                p0_transpose_item(INP(22), 6144, (bf16*)(ws + WS_CIN), LDK, kb * 64, n0, drow0, scr, lane);
            } else { const int r = it - E7, kb = r / 64, nb = r % 64;
                p0_transpose_item(INP(24), DM, (bf16*)(ws + WS_COUT), LDK, kb * 64, nb * 32, nb * 32, scr, lane); }
        }
        for (int m = gw; m < M; m += NGW) {
            const float* src = (m < MP) ? INP(0) + (size_t)m * DM : INP(1) + (size_t)(m - MP) * DM;
            const f32x4* xr = (const f32x4*)src + lane;
#pragma unroll
            for (int j = 0; j < 8; ++j) { const f32x4 v = __builtin_nontemporal_load(xr + 64 * j); v2u w; w.x = pk2(v.x, v.y); w.y = pk2(v.z, v.w); *(v2u*)(XB + xb_idx(m, 4 * (lane + 64 * j))) = w; }
        }
    }
    PH_END();

    for (int step = 0; step < 12; ++step) {
        const int L = step / 3, sub = step % 3, kind = L % 3, jm = L / 3;
        size_t og_a, og_b; int og_lda = LDK, og_ldb = LDK, og_K = DM, og_gt = 1 << 20, og_gk = 0, ocs_on = 0; long og_ksa = 128, og_ksb = 128; float os = 1.f;
        if (sub != 1) {
            const int hs = 2 * L + (sub == 2 ? 1 : 0);
            if (PH_ON()) {
                PH_PTRS();
                pg8::Gemm g{XB, (const bf16*)(ws + WS_WGU + (size_t)hs * SZ_WGU), 32, 32, DM, 1 << 20, 0, (long)M * 128, (long)2 * DFF * 128}; pg8::UpOrder S0{bx, 0}, S1{bx, 1};
                pg8::EpiSwiGLU E{ACT, DFF};
                for (int rep = 0; rep < REP_UP; ++rep, (rep < REP_UP ? xcd_barrier(bar, opaque_tid(wave_id)) : (void)0))
                { pg8::gemm_phase<pg8::EpiSwiGLU, pg8::UpOrder, true, true, 0>(lds + RING_OFF, g, S0, E, opaque_tid(wave_id)); pg8::gemm_phase<pg8::EpiSwiGLU, pg8::UpOrder, true, true, 1>(lds + RING_OFF, g, S1, E, opaque_tid(wave_id)); }
            }
            PH_END();
            og_a = WS_ACT; og_b = WS_WD + (size_t)hs * SZ_WD; og_lda = 64; og_ldb = 64; og_K = DFF; os = 0.5f; og_ksa = (long)M * 128; og_ksb = (long)DM * 128;
        } else if (kind == 0) {
            if (PH_ON()) {
                PH_PTRS();
                pg8::Gemm g{XB, (const bf16*)(ws + WS_AIN) + (size_t)jm * 4096 * LDK, 32, LDK, DM, 1 << 20, 0, (long)M * 128, 128}; pg8::DpOrder S; S.init(MP / 256, 16, G, bx, false);
                pg8::EpiBf16<1> E{UV, 4096, (float*)(ws + WS_VST) + (size_t)jm * M * 64};
                for (int rep = 0; rep < REP_MG; ++rep)
                pg8::gemm_phase<pg8::EpiBf16<1>, pg8::DpOrder, true, true, 1>(lds + RING_OFF, g, S, E, opaque_tid(wave_id));
            }
            PH_END();
            if (PH_ON()) {
                PH_IDS(); PH_PTRS();
                const float* WSm = INP(17) + (size_t)jm * 16 * 128 * 128; const float* BSm = INP(18) + (size_t)jm * 16 * 128;
                const float* lg = INP(15) + (size_t)jm * DM; const float* lb = INP(16) + (size_t)jm * DM; const float* VST = (const float*)(ws + WS_VST) + (size_t)jm * M * 64;
                LAS f32x2v* ST = (LAS f32x2v*)(lds + 40960);
                constexpr int VS = 272;
                const int fr = lane & 15, fq = lane >> 4;
                for (int rep = 0; rep < REP_MIX; ++rep) {
                for (int item = bx; item < 64 * 16; item += G) {
                    const int chunk = item >> 4, h = item & 15;
                    const int sr = tid >> 2, part = tid & 3; const f32x2v* ps = (const f32x2v*)(VST + (((size_t)chunk * 128 + sr) * 32 + part * 8) * 2);
                    f32x2v pp[8];
#pragma unroll
                    for (int k = 0; k < 8; ++k) pp[k] = ps[k];
                    const int ch = tid & 15, cb = h * 128 + ch * 8;
                    v4u vraw[4];
#pragma unroll
                    for (int i = 0; i < 4; ++i) vraw[i] = *(const v4u*)(UV + ((size_t)chunk * 128 + (tid >> 4) + 32 * i) * 4096 + 2048 + cb);
                    const f32x4 g0 = *(const f32x4*)(lg + cb), g1 = *(const f32x4*)(lg + cb + 4), b0 = *(const f32x4*)(lb + cb), b1 = *(const f32x4*)(lb + cb + 4);
                    const int t0 = 16 * wave, nks = (wave >> 1) + 1, trow = t0 + fr;
                    f32x4 wreg[4][2];
#pragma unroll
                    for (int ks = 0; ks < 4; ++ks) { const float* wp = WSm + ((size_t)(h * 128 + trow)) * 128 + 32 * ks + 8 * fq; wreg[ks][0] = *(const f32x4*)wp; wreg[ks][1] = *(const f32x4*)(wp + 4); }
                    const size_t row = (size_t)chunk * 128 + trow;
                    v2u uu[8];
#pragma unroll
                    for (int d = 0; d < 8; ++d) uu[d] = *(const v2u*)(UV + row * 4096 + h * 128 + 16 * d + 4 * fq);
                    const float bias = BSm[h * 128 + trow];
                    __syncthreads();
                    { float s1 = 0.f, s2 = 0.f;
#pragma unroll
                      for (int k = 0; k < 8; ++k) { s1 += pp[k].x; s2 += pp[k].y; }
#pragma unroll
                      for (int o = 1; o < 4; o <<= 1) { s1 += __builtin_bit_cast(float, __builtin_amdgcn_ds_bpermute((lane ^ o) << 2, __builtin_bit_cast(int, s1))); s2 += __builtin_bit_cast(float, __builtin_amdgcn_ds_bpermute((lane ^ o) << 2, __builtin_bit_cast(int, s2))); }
                      const float mean = s1 * (1.f / DM); if (part == 0) ST[sr] = (f32x2v){mean, 1.f / sqrtf(fmaxf(s2 * (1.f / DM) - mean * mean, 0.f) + LN_EPS)}; }
                    __syncthreads();
                    {
#pragma unroll
                      for (int i = 0; i < 4; ++i) { const int vrow = (tid >> 4) + 32 * i;
                        const v4u r = vraw[i]; const f32x2v st = ST[vrow]; const float mean = st.x, rstd = st.y;
                        v4u w; w.x = pk2((bflo(r.x) - mean) * rstd * g0[0] + b0[0], (bfhi(r.x) - mean) * rstd * g0[1] + b0[1]); w.y = pk2((bflo(r.y) - mean) * rstd * g0[2] + b0[2], (bfhi(r.y) - mean) * rstd * g0[3] + b0[3]);
                        w.z = pk2((bflo(r.z) - mean) * rstd * g1[0] + b1[0], (bfhi(r.z) - mean) * rstd * g1[1] + b1[1]); w.w = pk2((bflo(r.w) - mean) * rstd * g1[2] + b1[2], (bfhi(r.w) - mean) * rstd * g1[3] + b1[3]);
                        *(LAS v4u*)(lds + vrow * VS + ch * 16) = w; } }
                    __syncthreads();
                    f32x4 acc[8];
#pragma unroll
                    for (int d = 0; d < 8; ++d) acc[d] = (f32x4){0.f, 0.f, 0.f, 0.f};
#pragma unroll
                    for (int ks = 0; ks < 4; ++ks) if (ks < nks) {
                        const int s0 = 32 * ks + 8 * fq;
                        const f32x4 w0 = wreg[ks][0], w1 = wreg[ks][1];
                        float wv[8] = {w0[0], w0[1], w0[2], w0[3], w1[0], w1[1], w1[2], w1[3]};
#pragma unroll
                        for (int e = 0; e < 8; ++e) wv[e] = (s0 + e <= trow) ? wv[e] : 0.f;
                        v4u wpk; wpk.x = pk2(wv[0], wv[1]); wpk.y = pk2(wv[2], wv[3]); wpk.z = pk2(wv[4], wv[5]); wpk.w = pk2(wv[6], wv[7]);
                        const bf16x8 wfrag = __builtin_bit_cast(bf16x8, wpk);
                        LAS unsigned char* vb = lds + (32 * ks + 8 * fq + ((lane & 15) >> 2)) * VS + (4 * (lane & 3)) * 2;
#pragma unroll
                        for (int d = 0; d < 8; ++d) {
                            const s16x4 lo = __builtin_bit_cast(s16x4, __builtin_amdgcn_ds_read_tr16_b64_v4i16((LAS s16x4*)(vb + d * 32)));
                            const s16x4 hi4 = __builtin_bit_cast(s16x4, __builtin_amdgcn_ds_read_tr16_b64_v4i16((LAS s16x4*)(vb + d * 32 + 4 * VS)));
                            const bf16x8 vfrag = (bf16x8){lo[0], lo[1], lo[2], lo[3], hi4[0], hi4[1], hi4[2], hi4[3]};
                            acc[d] = __builtin_amdgcn_mfma_f32_16x16x32_bf16(vfrag, wfrag, acc[d], 0, 0, 0);
                        }
                    }
#pragma unroll
                    for (int d = 0; d < 8; ++d) { const int col = h * 128 + 16 * d + 4 * fq;
                        v2u o; o.x = pk2(bflo(uu[d].x) * (acc[d][0] + bias), bfhi(uu[d].x) * (acc[d][1] + bias)); o.y = pk2(bflo(uu[d].y) * (acc[d][2] + bias), bfhi(uu[d].y) * (acc[d][3] + bias));
                        *(v2u*)(T2 + row * LDK + col) = o; }
                }
                for (int idx = bx * 512 + tid; idx < DECB * 1024; idx += G * 512) {
                    const int sb = idx >> 10, c = (idx & 1023) * 2, h = c >> 7; const size_t r0 = (size_t)MP + sb * 8;
                    __syncthreads();
                    if (tid < 256) { const int r = tid >> 5, jj = tid & 31; const f32x2v p = *(const f32x2v*)(VST + ((r0 + r) * 32 + jj) * 2); float s1 = p.x, s2 = p.y;
#pragma unroll
                        for (int o = 1; o < 32; o <<= 1) { s1 += __builtin_bit_cast(float, __builtin_amdgcn_ds_bpermute((lane ^ o) << 2, __builtin_bit_cast(int, s1))); s2 += __builtin_bit_cast(float, __builtin_amdgcn_ds_bpermute((lane ^ o) << 2, __builtin_bit_cast(int, s2))); }
                        const float mean = s1 * (1.f / DM); if (jj == 0) ST[r] = (f32x2v){mean, 1.f / sqrtf(fmaxf(s2 * (1.f / DM) - mean * mean, 0.f) + LN_EPS)}; }
                    __syncthreads();
                    float v0[8], v1[8];
#pragma unroll
                    for (int s = 0; s < 8; ++s) { const unsigned r = *(const unsigned*)(UV + (r0 + s) * 4096 + 2048 + c); const f32x2v st = ST[s]; const float mean = st.x, rstd = st.y;
                        v0[s] = (bflo(r) - mean) * rstd * lg[c] + lb[c]; v1[s] = (bfhi(r) - mean) * rstd * lg[c + 1] + lb[c + 1];
                        float* o = OUT + OFF_CV + ((size_t)jm * MS + (r0 - MP) + s) * DM + c; o[0] = v0[s]; o[1] = v1[s]; }
#pragma unroll
                    for (int t = 0; t < 8; ++t) { float m0 = BSm[h * 128 + t], m1 = m0;
#pragma unroll
                        for (int s = 0; s < 8; ++s) if (s <= t) { const float w = WSm[(size_t)(h * 128 + t) * 128 + s]; m0 += w * v0[s]; m1 += w * v1[s]; }
                        const unsigned uu = *(const unsigned*)(UV + (r0 + t) * 4096 + c);
                        *(unsigned*)(T2 + (r0 + t) * LDK + c) = pk2(bflo(uu) * m0, bfhi(uu) * m1); }
                }
                }
            }
            PH_END();
            og_a = WS_T2; og_b = WS_AOUT + (size_t)jm * DM * LDK * 2;
        } else if (kind == 1) {
            if (PH_ON()) {
                PH_IDS(); PH_PTRS();
                const float* SP = INP(2) + (size_t)jm * DECB * 15 * DM;
                for (int rep = 0; rep < REP_POOL; ++rep) {
#define POOL_RAW(r, jj) (*(const v2u*)(XB + xb_idx((int)(r), 4 * (lane + 64 * (jj)))))
#define POOL_CV(w_) ((f32x4){bflo((w_).x), bfhi((w_).x), bflo((w_).y), bfhi((w_).y)})
#define POOL_LOAD(W, J, NH, rw) do { _Pragma("unroll") for (int h = 0; h < NH; ++h) _Pragma("unroll") for (int k = 0; k < W + 3; ++k) { const int rr = m0 - (W - 1) + k; rw[h][k] = POOL_RAW((rr < m0 - t0) ? m0 : rr, J + h); } } while (0)
#define POOL_OUT(W, J, NH, rw) do { _Pragma("unroll") for (int h = 0; h < NH; ++h) { f32x4 xf[W + 3]; _Pragma("unroll") for (int k = 0; k < W + 3; ++k) xf[k] = POOL_CV(rw[h][k]); \
                        _Pragma("unroll") for (int r = 0; r < 4; ++r) { const int t = t0 + r, cnt = (t + 1 < W) ? t + 1 : W; const f32x4 xc = xf[W - 1 + r]; f32x4 a = xc; \
                            _Pragma("unroll") for (int i = 1; i < W; ++i) a += (i < cnt) ? xf[W - 1 + r - i] : (f32x4){0.f, 0.f, 0.f, 0.f}; \
                            const f32x4 pv = a * (1.0f / (float)cnt) - xc; v2u o; o.x = pk2(pv[0], pv[1]); o.y = pk2(pv[2], pv[3]); *((v2u*)(T1 + (size_t)(m0 + r) * LDK) + lane + 64 * (J + h)) = o; \
                            if (t >= SEQ - 15) *((f32x4*)(OUT + OFF_PP + ((size_t)(jm * NBATCH + b) * 15 + (t - (SEQ - 15))) * DM) + lane + 64 * (J + h)) = xc; } } } while (0)
                for (int it = gw; it < MP / 4; it += NGW) {
                    const int m0 = 4 * it, t0 = m0 & (SEQ - 1), b = m0 >> 11;
                    v2u r2[2][5], r4[2][7]; POOL_LOAD(2, 0, 2, r2); POOL_LOAD(4, 2, 2, r4); POOL_OUT(2, 0, 2, r2);
                    v2u r8[2][11]; POOL_LOAD(8, 4, 2, r8); POOL_OUT(4, 2, 2, r4);
                    v2u ra[1][19]; POOL_LOAD(16, 6, 1, ra); POOL_OUT(8, 4, 2, r8);
                    v2u rb[1][19]; POOL_LOAD(16, 7, 1, rb); POOL_OUT(16, 6, 1, ra); POOL_OUT(16, 7, 1, rb);
                }
#undef POOL_LOAD
#undef POOL_OUT
                for (int it = gw; it < DECB * 8; it += NGW) {
                    const int sb = it >> 3, jj = it & 7, W = 2 << (jj >> 1); const size_t r0 = (size_t)MP + sb * 8;
                    f32x4 hs[15], xs[8];
#pragma unroll
                    for (int q = 0; q < 15; ++q) hs[q] = *((const f32x4*)(SP + ((size_t)sb * 15 + q) * DM) + lane + 64 * jj);
#pragma unroll
                    for (int t = 0; t < 8; ++t) { const v2u w_ = POOL_RAW(r0 + t, jj); xs[t] = POOL_CV(w_); }
                    float* ps = OUT + OFF_PS + ((size_t)(jm * DECB + sb) * 15) * DM;
#pragma unroll
                    for (int t = 0; t < 8; ++t) { const f32x4 xc = xs[t]; f32x4 a = xc;
#pragma unroll
                        for (int i = 1; i < 16; ++i) { const int q = 15 + t - i; const f32x4 xv = (q >= 15) ? xs[q >= 15 ? q - 15 : 0] : hs[q < 15 ? q : 0]; a += (i < W) ? xv : (f32x4){0.f, 0.f, 0.f, 0.f}; }
                        const f32x4 pv = a * (1.0f / (float)W) - xc; v2u o; o.x = pk2(pv[0], pv[1]); o.y = pk2(pv[2], pv[3]); *((v2u*)(T1 + (r0 + t) * LDK) + lane + 64 * jj) = o;
                        *((f32x4*)(ps + (size_t)(7 + t) * DM) + lane + 64 * jj) = xc;
                        if (t < 7) *((f32x4*)(ps + (size_t)t * DM) + lane + 64 * jj) = hs[8 + t]; }
                }
#undef POOL_RAW
#undef POOL_CV
                }
            }
            PH_END();
            og_a = WS_T1; og_b = WS_BGRP; og_ldb = 512; og_K = 512; og_gt = 2; og_gk = 512; ocs_on = 0;
        } else {
            if (PH_ON()) {
                PH_PTRS();
                pg8::Gemm g{XB, (const bf16*)(ws + WS_CIN), 32, LDK, DM, 1 << 20, 0, (long)M * 128, 128}; pg8::DpOrder S; S.init(MP / 256, 24, G, bx, false);
                pg8::EpiConvIn E{UV, OUT + OFF_CP + (size_t)jm * NBATCH * 2 * DM, OUT + OFF_CS + (size_t)jm * DECB * 2 * DM};
                for (int rep = 0; rep < REP_MG; ++rep)
                pg8::gemm_phase<pg8::EpiConvIn, pg8::DpOrder, true, true, 1>(lds + RING_OFF, g, S, E, opaque_tid(wave_id));
            }
            PH_END();
            if (PH_ON()) {
                PH_IDS(); PH_PTRS();
                const float* HC = INP(3) + (size_t)jm * DECB * 2 * DM; const float* WC = INP(23) + (size_t)jm * 3 * DM;
                for (int rep = 0; rep < REP_CG; ++rep)
                for (int m = gw; m < M; m += NGW) {
                    int t, sb = 0; if (m < MP) t = m & (SEQ - 1); else { const int lr = m - MP; sb = lr >> 3; t = lr & 7; }
#pragma unroll
                    for (int j = 0; j < 4; ++j) { const int c = 8 * (lane + 64 * j);
                        const v4u zb = *(const v4u*)(UV + (size_t)m * 4096 + 2048 + c), bb = *(const v4u*)(UV + (size_t)m * 4096 + c);
                        float z[8] = {bflo(zb.x), bfhi(zb.x), bflo(zb.y), bfhi(zb.y), bflo(zb.z), bfhi(zb.z), bflo(zb.w), bfhi(zb.w)};
                        float bg[8] = {bflo(bb.x), bfhi(bb.x), bflo(bb.y), bfhi(bb.y), bflo(bb.z), bfhi(bb.z), bflo(bb.w), bfhi(bb.w)};
                        float z1[8], z2[8];
                        if (t >= 1) { const v4u r = *(const v4u*)(UV + (size_t)(m - 1) * 4096 + 2048 + c);
                            z1[0] = bflo(r.x); z1[1] = bfhi(r.x); z1[2] = bflo(r.y); z1[3] = bfhi(r.y); z1[4] = bflo(r.z); z1[5] = bfhi(r.z); z1[6] = bflo(r.w); z1[7] = bfhi(r.w); }
                        else if (m >= MP) { const float* hp = HC + ((size_t)sb * 2 + 1) * DM + c;
#pragma unroll
                            for (int e = 0; e < 8; ++e) z1[e] = hp[e]; }
                        else {
#pragma unroll
                            for (int e = 0; e < 8; ++e) z1[e] = 0.f; }
                        if (t >= 2) { const v4u r = *(const v4u*)(UV + (size_t)(m - 2) * 4096 + 2048 + c);
                            z2[0] = bflo(r.x); z2[1] = bfhi(r.x); z2[2] = bflo(r.y); z2[3] = bfhi(r.y); z2[4] = bflo(r.z); z2[5] = bfhi(r.z); z2[6] = bflo(r.w); z2[7] = bfhi(r.w); }
                        else if (m >= MP) { const float* hp = HC + ((size_t)sb * 2 + t) * DM + c;
#pragma unroll
                            for (int e = 0; e < 8; ++e) z2[e] = hp[e]; }
                        else {
#pragma unroll
                            for (int e = 0; e < 8; ++e) z2[e] = 0.f; }
                        float o[8];
#pragma unroll
                        for (int e = 0; e < 8; ++e) o[e] = bg[e] * (WC[2 * DM + c + e] * z[e] + WC[DM + c + e] * z1[e] + WC[c + e] * z2[e]);
                        v4u w; w.x = pk2(o[0], o[1]); w.y = pk2(o[2], o[3]); w.z = pk2(o[4], o[5]); w.w = pk2(o[6], o[7]);
                        *(v4u*)(T1 + (size_t)m * LDK + c) = w; }
                }
            }
            PH_END();
            og_a = WS_T1; og_b = WS_COUT;
        }
        if (PH_ON()) {
            PH_PTRS();
            const pg8::Gemm og{(const bf16*)(ws + og_a), (const bf16*)(ws + og_b), og_lda, og_ldb, og_K, og_gt, og_gk, og_ksa, og_ksb};
#if FUSE_LN
            const int gi = (sub == 0) ? 8 : (sub == 1 ? 10 : 12);
            pg8::PanelOrder S{bx};
            pg8::EpiResidLN E{step == 11 ? X : nullptr, ocs_on ? INP(21) + (size_t)jm * DM : nullptr, os,
                              INP(gi) + (size_t)L * DM, INP(gi + 1) + (size_t)L * DM, XB, (unsigned long long*)(ws + WS_SLOT), ctl + CW_LN + step * LN_BANK, ctl + CW_TMO, (unsigned)(step + 1)};
            pg8::gemm_phase<pg8::EpiResidLN, pg8::PanelOrder, true, true, 1>(lds + RING_OFF, og, S, E, opaque_tid(wave_id));
#else
            pg8::DpOrder S; S.init(M / 256, 8, G, bx, SUB_ON);
            pg8::EpiResid E{step == 0 ? INP(0) : X, step == 0 ? INP(1) : X + (size_t)MP * DM, X, ocs_on ? INP(21) + (size_t)jm * DM : nullptr, os};
            for (int rep = 0; rep < (step == 0 ? REP_DOWN0 : 1); ++rep, (rep < (step == 0 ? REP_DOWN0 : 1) ? xcd_barrier(bar, opaque_tid(wave_id)) : (void)0))
            { pg8::gemm_phase<pg8::EpiResid, pg8::DpOrder, true, true>(lds + RING_OFF, og, S, E, opaque_tid(wave_id)); pg8::gemm_sub_phase<pg8::EpiResid, pg8::DpOrder>(lds + RING_OFF, og, S, E, opaque_tid(wave_id)); }
#endif
        }
        PH_END();
#if !FUSE_LN
        if (PH_ON()) {
            PH_IDS(); PH_PTRS();
            const int gi = (sub == 0) ? 8 : (sub == 1 ? 10 : 12);
            const float* lg = INP(gi) + (size_t)L * DM; const float* lb = INP(gi + 1) + (size_t)L * DM;
            for (int rep = 0; rep < REP_LN; ++rep)
            for (int m = gw; m < M; m += NGW) {
                const bool dummy = rep < REP_LN - 1;
                f32x4* xr = (f32x4*)(X + (size_t)m * DM) + lane; f32x4* xw = dummy ? (f32x4*)((float*)(ws + WS_PART) + (size_t)m * DM) + lane : xr;
                f32x4 v[8]; float s = 0.f;
#pragma unroll
                for (int j = 0; j < 8; ++j) { v[j] = xr[64 * j]; s += (v[j].x + v[j].y) + (v[j].z + v[j].w); }
                const float mean = wave_sum(s, lane) * (1.f / DM); float s2 = 0.f;
#pragma unroll
                for (int j = 0; j < 8; ++j) { v[j] = v[j] - mean; s2 += (v[j].x * v[j].x + v[j].y * v[j].y) + (v[j].z * v[j].z + v[j].w * v[j].w); }
                const float rstd = 1.f / sqrtf(wave_sum(s2, lane) * (1.f / DM) + LN_EPS);
                v2u* o8 = (v2u*)((dummy ? T2 : XB) + (size_t)m * LDK) + lane;
#pragma unroll
                for (int j = 0; j < 8; ++j) { const f32x4 gg = *((const f32x4*)lg + lane + 64 * j), bb = *((const f32x4*)lb + lane + 64 * j);
                    const f32x4 o = v[j] * rstd * gg + bb; xw[64 * j] = o; v2u w; w.x = pk2(o.x, o.y); w.y = pk2(o.z, o.w); o8[64 * j] = w; }
            }
        }
        PH_END();
#endif
    }
#undef PH_ON
#undef PH_END
#undef PH_IDS
#undef PH_PTRS
#undef INP
}

constexpr int N_PHASES = 1 + 8 * 3 + (4 + 3 + 4 + 4) - (FUSE_LN ? 12 : 0);

extern "C" void kernel_launch(void* const* d_in, const int* in_sizes, int n_in, void* d_out, int out_size, void* d_ws, size_t ws_size, hipStream_t stream) {
    static int grid = 0;
    if (grid == 0) {
        if (n_in != 25 || (size_t)out_size != OUT_TOTAL || ws_size < WS_END) { fprintf(stderr, "kernel_launch: unexpected shapes: n_in %d out %d ws %zu (need %zu)\n", n_in, out_size, ws_size, (size_t)WS_END); grid = -1; return; }
        int dev = 0, cus = 0, per_cu = 0;
        if (hipGetDevice(&dev) != hipSuccess || hipDeviceGetAttribute(&cus, hipDeviceAttributeMultiprocessorCount, dev) != hipSuccess) { grid = -1; return; }
        if (hipFuncSetAttribute((const void*)fwd_kernel, hipFuncAttributeMaxDynamicSharedMemorySize, LDS_BYTES) != hipSuccess) { fprintf(stderr, "kernel_launch: hipFuncSetAttribute failed\n"); grid = -1; return; }
        if (hipOccupancyMaxActiveBlocksPerMultiprocessor(&per_cu, (const void*)fwd_kernel, NWAVES * 64, LDS_BYTES) != hipSuccess || per_cu < 1)
            fprintf(stderr, "kernel_launch: note: occupancy query reports %d workgroups per CU\n", per_cu);
        (void)hipGetLastError();
        grid = cus;
    }
    if (grid < 0) return;
    if (hipMemsetAsync((char*)d_ws + WS_CTL, 0, CTL_ZERO_BYTES, stream) != hipSuccess) { fprintf(stderr, "kernel_launch: memset failed\n"); return; }
    Args a{};
    for (int i = 0; i < 25; ++i) a.in[i] = (const float*)d_in[i];
    a.out = (float*)d_out; a.ws = (unsigned char*)d_ws;
#if MK_PER_PHASE
    for (int p = 0; p < N_PHASES; ++p) { a.ph_lo = p; a.ph_hi = p + 1; hipLaunchKernelGGL(fwd_kernel, dim3(grid), dim3(NWAVES * 64), LDS_BYTES, stream, a); }
#else
    a.ph_lo = 0; a.ph_hi = N_PHASES;
    hipLaunchKernelGGL(fwd_kernel, dim3(grid), dim3(NWAVES * 64), LDS_BYTES, stream, a);
#endif
    const hipError_t le = hipPeekAtLastError();
    if (le != hipSuccess) fprintf(stderr, "kernel_launch: launch failed: %s\n", hipGetErrorName(le));
}
```
